# Optimizing an MI355X kernel written in HIP

```python
import math
import jax, jax.numpy as jnp
from jax import lax
import numpy as np

D_MODEL = 1024
BATCH = 2
SEQ = 8192
DEPTH = 1
DEC_BATCH = 128
DEC_SEQ = 8
PAST_LEN = 8192
PAGE_SIZE = 128

N_META = 16
D_ATTN = D_MODEL // 2
HEAD_DIM = 64
N_HEADS = D_ATTN // HEAD_DIM
N_KV_HEADS = 2
GQA_GROUP = N_HEADS // N_KV_HEADS
D_KV = N_KV_HEADS * HEAD_DIM
WINDOW = 128
BLOCK = 128
ROPE_THETA = 10000.0
D_SSM = D_MODEL - D_ATTN
SSM_GROUP = 16
N_SSM_GROUPS = D_SSM // SSM_GROUP
SSM_STATE = 64
D_MIX = D_ATTN + D_SSM
D_IN_PROJ = D_ATTN + 2 * D_KV + D_ATTN + D_SSM + D_SSM
EPS = 1e-6
NEG_INF = -1e30
DT_MIN = 0.001
DT_MAX = 0.1

kernel_name = "hymba_swa_sink_s5_decode_step"


def rmsnorm(x, w):
    xf = x.astype(jnp.float32)
    y = xf * lax.rsqrt(jnp.mean(xf * xf, axis=-1, keepdims=True) + EPS)
    return (y * w.astype(jnp.float32)).astype(x.dtype)


def rope(x, pos):
    inv = ROPE_THETA ** (-jnp.arange(0, HEAD_DIM, 2, dtype=jnp.float32) / HEAD_DIM)
    ang = pos.astype(jnp.float32)[:, None] * inv[None, :]
    cos = jnp.concatenate([jnp.cos(ang), jnp.cos(ang)], -1)[None, :, None, :]
    sin = jnp.concatenate([jnp.sin(ang), jnp.sin(ang)], -1)[None, :, None, :]
    xf = x.astype(jnp.float32)
    x1, x2 = jnp.split(xf, 2, axis=-1)
    rot = jnp.concatenate([-x2, x1], -1)
    return (xf * cos + rot * sin).astype(x.dtype)


def project(x, pos, norm_w, w_in, q_norm_w, k_norm_w):
    B, L, _ = x.shape
    xn = rmsnorm(x, norm_w)
    z = xn @ w_in
    cuts = [D_ATTN, D_ATTN + D_KV, D_ATTN + 2 * D_KV, 2 * D_ATTN + 2 * D_KV,
            2 * D_ATTN + 2 * D_KV + D_SSM]
    q, k, v, g_attn, u, g_ssm = jnp.split(z, cuts, axis=-1)
    q = rope(rmsnorm(q.reshape(B, L, N_HEADS, HEAD_DIM), q_norm_w), pos)
    k = rope(rmsnorm(k.reshape(B, L, N_KV_HEADS, HEAD_DIM), k_norm_w), pos)
    v = v.reshape(B, L, N_KV_HEADS, HEAD_DIM)
    return q, k, v, g_attn, u, g_ssm


def sink_softmax(s, mask, sinks):
    s = jnp.where(mask, s, NEG_INF)
    sink = jnp.broadcast_to(sinks.astype(jnp.float32).reshape(N_KV_HEADS, GQA_GROUP)[:, :, None, None],
                            s.shape[:-1] + (1,))
    p = jax.nn.softmax(jnp.concatenate([s, sink], axis=-1), axis=-1)
    return p[..., :-1]


def attn_prompt(q, k, v, sinks):
    B, L = q.shape[:2]
    pad_front = (BLOCK - N_META % BLOCK) % BLOCK
    pad_back = (-(L + pad_front)) % BLOCK
    L_pad = L + pad_front + pad_back
    nb = L_pad // BLOCK
    padw = ((0, 0), (pad_front, pad_back), (0, 0), (0, 0))
    qb = jnp.pad(q, padw).reshape(B, nb, BLOCK, N_KV_HEADS, GQA_GROUP, HEAD_DIM)
    kb = jnp.pad(k, padw).reshape(B, nb, BLOCK, N_KV_HEADS, HEAD_DIM)
    vb = jnp.pad(v, padw).reshape(B, nb, BLOCK, N_KV_HEADS, HEAD_DIM)
    prev = lambda t: jnp.pad(t, ((0, 0), (1, 0), (0, 0), (0, 0), (0, 0)))[:, :-1]
    kc = jnp.concatenate([prev(kb), kb], axis=2)
    vc = jnp.concatenate([prev(vb), vb], axis=2)
    pos = (jnp.arange(L_pad, dtype=jnp.int32) - pad_front).reshape(nb, BLOCK)
    valid = (pos >= 0) & (pos < L)
    pos_kc = jnp.concatenate([jnp.pad(pos, ((1, 0), (0, 0)), constant_values=-1)[:-1], pos], 1)
    valid_kc = jnp.concatenate([jnp.pad(valid, ((1, 0), (0, 0)), constant_values=False)[:-1], valid], 1)
    diff = pos[:, :, None] - pos_kc[:, None, :]
    mask = (diff >= 0) & (diff < WINDOW) & valid_kc[:, None, :]
    s = jnp.einsum('bnqkgd,bnskd->bnkgqs', qb, kc).astype(jnp.float32) / math.sqrt(HEAD_DIM)
    p = sink_softmax(s, mask[None, :, None, None], sinks).astype(vc.dtype)
    o = jnp.einsum('bnkgqs,bnskd->bnqkgd', p, vc)
    o = o.reshape(B, L_pad, N_HEADS * HEAD_DIM)
    return o[:, pad_front:pad_front + L]


def attn_sample(q, k_new, v_new, cache_k, cache_v, sinks):
    DB, T = q.shape[:2]
    Wc = cache_k.shape[1]
    kc = jnp.concatenate([cache_k.astype(k_new.dtype), k_new], axis=1)
    vc = jnp.concatenate([cache_v.astype(v_new.dtype), v_new], axis=1)
    pos_q = PAST_LEN + jnp.arange(T, dtype=jnp.int32)
    pos_k = jnp.concatenate([PAST_LEN - Wc + jnp.arange(Wc, dtype=jnp.int32), pos_q])
    diff = pos_q[:, None] - pos_k[None, :]
    mask = (diff >= 0) & (diff < WINDOW)
    qg = q.reshape(DB, T, N_KV_HEADS, GQA_GROUP, HEAD_DIM)
    s = jnp.einsum('btkgd,bskd->bkgts', qg, kc).astype(jnp.float32) / math.sqrt(HEAD_DIM)
    p = sink_softmax(s, mask[None, None, None], sinks).astype(vc.dtype)
    o = jnp.einsum('bkgts,bskd->btkgd', p, vc)
    return o.reshape(DB, T, N_HEADS * HEAD_DIM)


def ssm_discretize(A_re, A_im, log_dt, B_re, B_im):
    A_re = A_re.astype(jnp.float32); A_im = A_im.astype(jnp.float32)
    dt = jnp.exp(log_dt.astype(jnp.float32))[:, None]
    mag = jnp.exp(dt * A_re)
    lam_re = mag * jnp.cos(dt * A_im)
    lam_im = mag * jnp.sin(dt * A_im)
    den = A_re * A_re + A_im * A_im
    f_re = ((lam_re - 1.0) * A_re + lam_im * A_im) / den
    f_im = (lam_im * A_re - (lam_re - 1.0) * A_im) / den
    Br = B_re.astype(jnp.float32); Bi = B_im.astype(jnp.float32)
    Bbar_re = f_re[..., None] * Br - f_im[..., None] * Bi
    Bbar_im = f_re[..., None] * Bi + f_im[..., None] * Br
    return lam_re, lam_im, Bbar_re, Bbar_im


def _scan_op(e1, e2):
    a1r, a1i, b1r, b1i = e1
    a2r, a2i, b2r, b2i = e2
    return (a2r * a1r - a2i * a1i,
            a2r * a1i + a2i * a1r,
            a2r * b1r - a2i * b1i + b2r,
            a2r * b1i + a2i * b1r + b2i)


def ssm_scan(u, h0_re, h0_im, A_re, A_im, log_dt, B_re, B_im, C_re, C_im, D_skip):
    Bsz, L, _ = u.shape
    uf = u.astype(jnp.float32).reshape(Bsz, L, N_SSM_GROUPS, SSM_GROUP)
    lam_re, lam_im, Bbar_re, Bbar_im = ssm_discretize(A_re, A_im, log_dt, B_re, B_im)
    bu_re = jnp.einsum('blgh,gnh->blgn', uf, Bbar_re)
    bu_im = jnp.einsum('blgh,gnh->blgn', uf, Bbar_im)
    h0r = h0_re.astype(jnp.float32); h0i = h0_im.astype(jnp.float32)
    bu_re = bu_re.at[:, 0].add(lam_re * h0r - lam_im * h0i)
    bu_im = bu_im.at[:, 0].add(lam_re * h0i + lam_im * h0r)
    a_re = jnp.broadcast_to(lam_re, bu_re.shape)
    a_im = jnp.broadcast_to(lam_im, bu_im.shape)
    _, _, x_re, x_im = lax.associative_scan(_scan_op, (a_re, a_im, bu_re, bu_im), axis=1)
    y = (jnp.einsum('blgn,ghn->blgh', x_re, C_re.astype(jnp.float32))
         - jnp.einsum('blgn,ghn->blgh', x_im, C_im.astype(jnp.float32))
         + D_skip.astype(jnp.float32) * uf)
    return y.reshape(Bsz, L, D_SSM), x_re[:, -1], x_im[:, -1]


def merge(x, attn_o, g_attn, ssm_y, g_ssm, attn_out_norm_w, w_glu, b_glu, ssm_out_norm_w, w_out):
    a = rmsnorm(attn_o * jax.nn.silu(g_attn), attn_out_norm_w)
    g = jax.nn.gelu(ssm_y.astype(x.dtype))
    s = g * jax.nn.sigmoid(g @ w_glu + b_glu)
    s = rmsnorm(s * jax.nn.silu(g_ssm), ssm_out_norm_w)
    return x + jnp.concatenate([a, s], axis=-1) @ w_out


def setup_inputs(seed: int = 0) -> dict:
    key = jax.random.key(seed)
    ks = jax.random.split(key, 24)
    f32 = jnp.float32
    nrm = lambda k, shape, scale: scale * jax.random.normal(k, shape, f32)
    x_prompt = nrm(ks[0], (BATCH, SEQ, D_MODEL), 1.0)
    x_sample = nrm(ks[1], (DEC_BATCH, DEC_SEQ, D_MODEL), 1.0)
    cache_k = nrm(ks[2], (DEPTH, DEC_BATCH, WINDOW, N_KV_HEADS, HEAD_DIM), 1.0)
    cache_v = nrm(ks[3], (DEPTH, DEC_BATCH, WINDOW, N_KV_HEADS, HEAD_DIM), 1.0)
    state_ssm_re = nrm(ks[4], (DEPTH, DEC_BATCH, N_SSM_GROUPS, SSM_STATE), 0.3)
    state_ssm_im = nrm(ks[5], (DEPTH, DEC_BATCH, N_SSM_GROUPS, SSM_STATE), 0.3)
    meta_tokens = nrm(ks[6], (N_META, D_MODEL), 1.0)
    norm_w = 1.0 + nrm(ks[7], (DEPTH, D_MODEL), 0.02)
    w_in = nrm(ks[8], (DEPTH, D_MODEL, D_IN_PROJ), D_MODEL ** -0.5)
    q_norm_w = 1.0 + nrm(ks[9], (DEPTH, HEAD_DIM), 0.02)
    k_norm_w = 1.0 + nrm(ks[10], (DEPTH, HEAD_DIM), 0.02)
    sinks = nrm(ks[11], (DEPTH, N_HEADS), 1.0)
    attn_out_norm_w = 1.0 + nrm(ks[12], (DEPTH, D_ATTN), 0.02)
    n_idx = jnp.arange(SSM_STATE, dtype=f32)
    ssm_A_re = -0.5 + nrm(ks[13], (DEPTH, N_SSM_GROUPS, SSM_STATE), 0.01)
    ssm_A_im = jnp.broadcast_to(math.pi * n_idx, (DEPTH, N_SSM_GROUPS, SSM_STATE)) \
        + nrm(ks[14], (DEPTH, N_SSM_GROUPS, SSM_STATE), 0.01)
    ssm_log_dt = jax.random.uniform(ks[15], (DEPTH, N_SSM_GROUPS), f32,
                                    math.log(DT_MIN), math.log(DT_MAX))
    ssm_B_re = nrm(ks[16], (DEPTH, N_SSM_GROUPS, SSM_STATE, SSM_GROUP), (2.0 * SSM_GROUP) ** -0.5)
    ssm_B_im = nrm(ks[17], (DEPTH, N_SSM_GROUPS, SSM_STATE, SSM_GROUP), (2.0 * SSM_GROUP) ** -0.5)
    ssm_C_re = nrm(ks[18], (DEPTH, N_SSM_GROUPS, SSM_GROUP, SSM_STATE), SSM_STATE ** -0.5)
    ssm_C_im = nrm(ks[19], (DEPTH, N_SSM_GROUPS, SSM_GROUP, SSM_STATE), SSM_STATE ** -0.5)
    ssm_D = nrm(ks[20], (DEPTH, N_SSM_GROUPS, SSM_GROUP), 1.0)
    w_glu = nrm(ks[21], (DEPTH, D_SSM, D_SSM), D_SSM ** -0.5)
    b_glu = nrm(ks[22], (DEPTH, D_SSM), 0.01)
    k2 = jax.random.split(ks[23], 2)
    ssm_out_norm_w = 1.0 + nrm(k2[0], (DEPTH, D_SSM), 0.02)
    w_out = nrm(k2[1], (DEPTH, D_MIX, D_MODEL), D_MIX ** -0.5)
    return {"x_prompt": x_prompt, "x_sample": x_sample,
            "cache_k": cache_k, "cache_v": cache_v,
            "state_ssm_re": state_ssm_re, "state_ssm_im": state_ssm_im,
            "meta_tokens": meta_tokens, "norm_w": norm_w, "w_in": w_in,
            "q_norm_w": q_norm_w, "k_norm_w": k_norm_w, "sinks": sinks,
            "attn_out_norm_w": attn_out_norm_w,
            "ssm_A_re": ssm_A_re, "ssm_A_im": ssm_A_im, "ssm_log_dt": ssm_log_dt,
            "ssm_B_re": ssm_B_re, "ssm_B_im": ssm_B_im, "ssm_C_re": ssm_C_re, "ssm_C_im": ssm_C_im,
            "ssm_D": ssm_D, "w_glu": w_glu, "b_glu": b_glu, "ssm_out_norm_w": ssm_out_norm_w,
            "w_out": w_out}


def reference(x_prompt, x_sample, cache_k, cache_v, state_ssm_re, state_ssm_im,
              meta_tokens, norm_w, w_in, q_norm_w, k_norm_w, sinks, attn_out_norm_w,
              ssm_A_re, ssm_A_im, ssm_log_dt, ssm_B_re, ssm_B_im, ssm_C_re, ssm_C_im,
              ssm_D, w_glu, b_glu, ssm_out_norm_w, w_out):
    Bp = x_prompt.shape[0]
    meta = jnp.broadcast_to(meta_tokens[None].astype(x_prompt.dtype), (Bp, N_META, D_MODEL))
    hp = jnp.concatenate([meta, x_prompt], axis=1)
    Lp = hp.shape[1]
    pos_p = jnp.arange(Lp, dtype=jnp.int32)
    hs = x_sample
    pos_s = PAST_LEN + jnp.arange(hs.shape[1], dtype=jnp.int32)
    kp_l, vp_l, srp_l, sip_l, ks_l, vs_l, srs_l, sis_l = [], [], [], [], [], [], [], []
    for l in range(DEPTH):
        q, k, v, ga, u, gs = project(hp, pos_p, norm_w[l], w_in[l], q_norm_w[l], k_norm_w[l])
        ao = attn_prompt(q, k, v, sinks[l])
        h0 = jnp.zeros((Bp, N_SSM_GROUPS, SSM_STATE), jnp.float32)
        sy, hr, hi = ssm_scan(u, h0, h0, ssm_A_re[l], ssm_A_im[l], ssm_log_dt[l],
                              ssm_B_re[l], ssm_B_im[l], ssm_C_re[l], ssm_C_im[l], ssm_D[l])
        hp = merge(hp, ao, ga, sy, gs, attn_out_norm_w[l], w_glu[l], b_glu[l],
                   ssm_out_norm_w[l], w_out[l])
        kp_l.append(k[:, -WINDOW:]); vp_l.append(v[:, -WINDOW:])
        srp_l.append(hr); sip_l.append(hi)
        q, k, v, ga, u, gs = project(hs, pos_s, norm_w[l], w_in[l], q_norm_w[l], k_norm_w[l])
        ao = attn_sample(q, k, v, cache_k[l], cache_v[l], sinks[l])
        sy, hr, hi = ssm_scan(u, state_ssm_re[l], state_ssm_im[l], ssm_A_re[l], ssm_A_im[l],
                              ssm_log_dt[l], ssm_B_re[l], ssm_B_im[l], ssm_C_re[l], ssm_C_im[l],
                              ssm_D[l])
        hs = merge(hs, ao, ga, sy, gs, attn_out_norm_w[l], w_glu[l], b_glu[l],
                   ssm_out_norm_w[l], w_out[l])
        ks_l.append(k); vs_l.append(v); srs_l.append(hr); sis_l.append(hi)
    y_prompt = hp[:, N_META:]
    y_sample = hs
    k_win_prompt = jnp.stack(kp_l); v_win_prompt = jnp.stack(vp_l)
    ssm_re_prompt = jnp.stack(srp_l).astype(state_ssm_re.dtype)
    ssm_im_prompt = jnp.stack(sip_l).astype(state_ssm_im.dtype)
    k_new_sample = jnp.stack(ks_l); v_new_sample = jnp.stack(vs_l)
    ssm_re_sample = jnp.stack(srs_l).astype(state_ssm_re.dtype)
    ssm_im_sample = jnp.stack(sis_l).astype(state_ssm_im.dtype)
    return (y_prompt, y_sample, k_win_prompt, v_win_prompt, ssm_re_prompt, ssm_im_prompt,
            k_new_sample, v_new_sample, ssm_re_sample, ssm_im_sample)
```

```cpp
#include <hip/hip_runtime.h>
#include <hip/hip_cooperative_groups.h>
#include <cstdio>
#include <cstdint>
namespace cg = cooperative_groups;

#ifndef SINGLE_LAUNCH
#define SINGLE_LAUNCH 1
#endif

#define DEVI __device__ __forceinline__
typedef unsigned short bf16_t;
typedef short bf16x8 __attribute__((ext_vector_type(8)));
typedef float f32x4 __attribute__((ext_vector_type(4)));
typedef float f32x16 __attribute__((ext_vector_type(16)));
typedef unsigned u32x2 __attribute__((ext_vector_type(2)));
typedef float f32x2 __attribute__((ext_vector_type(2)));
typedef unsigned u32x4 __attribute__((ext_vector_type(4)));

constexpr int LP = 8208;
constexpr int NPR = 2 * LP;
constexpr int NROWS = NPR + 1024;
constexpr int NROWS_PAD = 17664;
constexpr int NBLK = 514 + 640;
constexpr float EPS = 1e-6f;
constexpr float LOG2E = 1.4426950408889634f;
constexpr float QSCALE = 0.125f * LOG2E;

constexpr size_t O_YP = 0, O_YS = 16777216, O_KWP = 17825792, O_VWP = 17858560, O_SRP = 17891328, O_SIP = 17895424,
                 O_KNS = 17899520, O_VNS = 18030592, O_SRS = 18161664, O_SIS = 18423808;

constexpr size_t al256(size_t x) { return (x + 255) & ~(size_t)255; }
constexpr size_t W_BAR = 0;
constexpr size_t W_XB = 16384;
constexpr size_t W_RS = al256(W_XB + (size_t)NROWS_PAD * 1024 * 2);
constexpr size_t W_WINT = al256(W_RS + (size_t)NROWS_PAD * 4);
constexpr size_t W_WGLUT = al256(W_WINT + (size_t)2304 * 1024 * 2);
constexpr size_t W_WOUTT = al256(W_WGLUT + (size_t)512 * 512 * 2);
constexpr size_t W_ROPE = al256(W_WOUTT + (size_t)1024 * 1024 * 2);
constexpr size_t W_LAM = al256(W_ROPE + (size_t)LP * 32 * 8);
constexpr size_t W_LAM64 = al256(W_LAM + 32 * 64 * 8);
constexpr size_t W_BBARF = al256(W_LAM64 + 32 * 64 * 8);
constexpr size_t W_CMF = al256(W_BBARF + 32 * 4 * 64 * 8 * 2);
constexpr size_t W_QB = al256(W_CMF + 32 * 4 * 64 * 8 * 2);
constexpr size_t W_KF = al256(W_QB + (size_t)NROWS_PAD * 512 * 2);
constexpr size_t W_VF = al256(W_KF + (size_t)2 * NBLK * 4 * 64 * 8 * 2);
constexpr size_t W_GA = al256(W_VF + (size_t)2 * NBLK * 4 * 64 * 8 * 2);
constexpr size_t W_GS = al256(W_GA + (size_t)NROWS_PAD * 512 * 2);
constexpr size_t W_UG = al256(W_GS + (size_t)NROWS_PAD * 512 * 2);
constexpr size_t W_CAT = W_XB;
constexpr size_t W_SSQA = al256(W_UG + (size_t)NROWS_PAD * 512 * 2);
constexpr size_t W_GB = W_QB;
constexpr size_t W_GBS = al256(W_SSQA + (size_t)NROWS_PAD * 8 * 4);
constexpr size_t W_SSQS = al256(W_GBS + (size_t)1024 * 512 * 2);
DEVI bf16_t* gb_base(char* ws, bool sample_rows) { return sample_rows ? (bf16_t*)(ws + W_GBS) - (size_t)16384 * 512 : (bf16_t*)(ws + W_GB); }
constexpr size_t W_ENDS = al256(W_SSQS + (size_t)NROWS_PAD * 8 * 4);
constexpr size_t W_CARRY = al256(W_ENDS + (size_t)2 * 32 * 128 * 64 * 8);
constexpr size_t W_TOTAL = al256(W_CARRY + (size_t)2 * 32 * 129 * 64 * 8);

constexpr int LDS_XB = 131072 + 4096;
constexpr int LDS_BYTES = LDS_XB + 64;

struct P {
    const float *x_prompt, *x_sample, *cache_k, *cache_v, *st_re, *st_im, *meta, *norm_w, *w_in, *q_norm_w, *k_norm_w, *sinks,
        *aon_w, *A_re, *A_im, *log_dt, *B_re, *B_im, *C_re, *C_im, *Dk, *w_glu, *b_glu, *son_w, *w_out;
    float* out;
    char* ws;
};

DEVI int tidx() { int t = threadIdx.x; asm volatile("" : "+v"(t)); return t; }
constexpr int NROWS3 = 17408;
DEVI int row3_of(int row) {
    if (row >= NPR) return 16384 + (row - NPR);
    const int b = row >= LP ? 1 : 0, pos = row - b * LP;
    return pos >= 16 ? b * 8192 + pos - 16 : NROWS3 + b * 16 + pos;
}
DEVI unsigned pk2(float lo, float hi) { unsigned r; asm volatile("v_cvt_pk_bf16_f32 %0, %1, %2" : "=v"(r) : "v"(lo), "v"(hi)); return r; }
DEVI bf16_t f2bf(float f) { return (bf16_t)(pk2(f, 0.f) & 0xffffu); }
DEVI float bf2f(unsigned short b) { return __uint_as_float(((unsigned)b) << 16); }
DEVI float bflo(unsigned w) { return __uint_as_float(w << 16); }
DEVI float bfhi(unsigned w) { return __uint_as_float(w & 0xffff0000u); }
DEVI float silu_f(float x) { return x * __builtin_amdgcn_rcpf(1.f + __expf(-x)); }
DEVI float sigmoid_f(float x) { return __builtin_amdgcn_rcpf(1.f + __expf(-x)); }
DEVI float gelu_tanh(float x) {
    const float u = 1.5957691216057308f * (x + 0.044715f * x * x * x);
    return x * __builtin_amdgcn_rcpf(1.f + __expf(-u));
}
DEVI f32x4 mfma16(bf16x8 a, bf16x8 b, f32x4 c) { return __builtin_amdgcn_mfma_f32_16x16x32_bf16(a, b, c, 0, 0, 0); }
DEVI f32x16 mfma32(bf16x8 a, bf16x8 b, f32x16 c) { return __builtin_amdgcn_mfma_f32_32x32x16_bf16(a, b, c, 0, 0, 0); }
DEVI bf16x8 mk8(unsigned a, unsigned b, unsigned c, unsigned d) { u32x4 t = {a, b, c, d}; return __builtin_bit_cast(bf16x8, t); }


#define XB_TMO      128
#define XB_XCNT(j)  (256  + 64 * (j))
#define XB_XSUB(j)  (1280 + 64 * (j))
#define XB_XGEN(j)  (2304 + 64 * (j))
#define XB_TOP      3328
#define XB_TOPGEN   3392
#define XCD_BAR_WORDS 3456
#define XB_SPIN_CAP (1u << 18)
#define LAS __attribute__((address_space(3)))
DEVI unsigned xb_ld(unsigned* p) { return __hip_atomic_load(p, __ATOMIC_RELAXED, __HIP_MEMORY_SCOPE_AGENT); }
DEVI unsigned xb_add(unsigned* p, unsigned v) { return __hip_atomic_fetch_add(p, v, __ATOMIC_RELAXED, __HIP_MEMORY_SCOPE_AGENT); }
DEVI unsigned xb_xcc_id() { return (unsigned)__builtin_amdgcn_s_getreg((3 << 11) | 20) & 0xFu; }
#define XB_SPIN(cond, bar) do { unsigned _sp = 0; while (cond) { __builtin_amdgcn_s_sleep(1); \
    if ((++_sp & 255u) == 0u) { if (xb_ld(&(bar)[XB_TMO])) break; if (_sp > XB_SPIN_CAP) { atomicAdd(&(bar)[XB_TMO], 1u); break; } } } } while (0)
struct XcdBarrier { unsigned* bar; unsigned x; volatile LAS unsigned* st; };
DEVI XcdBarrier xcd_barrier_post(unsigned* bar, volatile LAS unsigned* st) {
    XcdBarrier b; b.bar = bar; b.x = xb_xcc_id(); b.st = st;
    if (tidx() == 0) (void)xb_add(&bar[XB_XCNT(b.x)], 1u);
    return b;
}
DEVI void xcd_barrier_complete(unsigned* bar, unsigned x, unsigned& nloc, unsigned& nx) {
    const unsigned G = gridDim.x * gridDim.y * gridDim.z;
    unsigned sum, cnt, mine, sp = 0u;
    for (;;) {
        sum = 0u; cnt = 0u; mine = 0u;
#pragma unroll
        for (unsigned j = 0; j < 16; ++j) { const unsigned c = xb_ld(&bar[XB_XCNT(j)]); sum += c; cnt += (c > 0u) ? 1u : 0u; mine = (j == x) ? c : mine; }
        if (sum == G) break;
        __builtin_amdgcn_s_sleep(1);
        if ((++sp & 255u) == 0u) { if (xb_ld(&bar[XB_TMO])) break; if (sp > XB_SPIN_CAP) { atomicAdd(&bar[XB_TMO], 1u); break; } }
    }
    nloc = mine > 0u ? mine : 1u; nx = cnt > 0u ? cnt : 1u;
}
DEVI void xcd_barrier(const XcdBarrier& b) {
    asm volatile("s_waitcnt vmcnt(0)" ::: "memory");
    __syncthreads();
    if (tidx() == 0) {
        unsigned* bar = b.bar;
        __builtin_amdgcn_s_waitcnt(0);
        unsigned nloc = b.st[0], nx = b.st[1];
        if (nloc == 0u) { xcd_barrier_complete(bar, b.x, nloc, nx); b.st[0] = nloc; b.st[1] = nx; }
        const unsigned old = xb_add(&bar[XB_XSUB(b.x)], 1u);
        const unsigned gen = old / nloc;
        if (old + 1u == (gen + 1u) * nloc) {
            __builtin_amdgcn_fence(__ATOMIC_RELEASE, "agent");
            asm volatile("s_waitcnt vmcnt(0)" ::: "memory");
            const unsigned og = xb_add(&bar[XB_TOP], 1u);
            const unsigned tg = og / nx;
            if (og + 1u == (tg + 1u) * nx) xb_add(&bar[XB_TOPGEN], 1u);
            else XB_SPIN(xb_ld(&bar[XB_TOPGEN]) == tg, bar);
            __builtin_amdgcn_fence(__ATOMIC_ACQUIRE, "agent");
            xb_add(&bar[XB_XGEN(b.x)], 1u);
            asm volatile("s_waitcnt vmcnt(0)" ::: "memory");
        } else {
            XB_SPIN(xb_ld(&bar[XB_XGEN(b.x)]) == gen, bar);
            __builtin_amdgcn_fence(__ATOMIC_ACQUIRE, "agent");
            asm volatile("s_waitcnt vmcnt(0)" ::: "memory");
        }
    }
    __syncthreads();
}

DEVI const float* row_src(const P& p, int r) {
    if (r < NPR) { const int b = r >= LP ? 1 : 0, pos = r - b * LP; return pos < 16 ? p.meta + (size_t)pos * 1024 : p.x_prompt + ((size_t)b * 8192 + pos - 16) * 1024; }
    if (r < NROWS) return p.x_sample + (size_t)(r - NPR) * 1024;
    return nullptr;
}

DEVI void p0_ssm_f(const P& p, int i, float& fre, float& fim, float2& lamv, float2& lam64v) {
    const int g = i >> 6;
    const double dt = exp((double)p.log_dt[g]), are = p.A_re[i], aim = p.A_im[i];
    const double mag = exp(dt * are);
    double th = dt * aim * 0.15915494309189535; th -= rint(th); th *= 6.283185307179586;
    const float thf = (float)th; const float sh = sinf(0.5f * thf);
    const double lr = mag * (double)cosf(thf), li = mag * (double)sinf(thf);
    const double lrm1 = expm1(dt * are) - mag * 2.0 * (double)sh * (double)sh;
    lamv = make_float2((float)lr, (float)li);
    const double mag64 = exp(64.0 * dt * are);
    double th64 = 64.0 * dt * aim * 0.15915494309189535; th64 -= rint(th64); th64 *= 6.283185307179586;
    lam64v = make_float2((float)(mag64 * (double)cosf((float)th64)), (float)(mag64 * (double)sinf((float)th64)));
    const double den = are * are + aim * aim;
    fre = (float)((lrm1 * are + li * aim) / den); fim = (float)((li * are - lrm1 * aim) / den);
}

DEVI void phase0(const P& p) {
    const int gtid = blockIdx.x * 512 + tidx(), gsz = gridDim.x * 512;
    const int gw = gtid >> 6, nw = gsz >> 6, lane = tidx() & 63;
    bf16_t* xb = (bf16_t*)(p.ws + W_XB); float* rs = (float*)(p.ws + W_RS);
    for (int r = gw * 2; r < NROWS_PAD; r += nw * 2) {
        const float* src0 = row_src(p, r); const float* src1 = row_src(p, r + 1);
        f32x4 v[2][4]; float ss0 = 0.f, ss1 = 0.f;
#pragma unroll
        for (int i = 0; i < 4; ++i) {
            v[0][i] = src0 ? *(const f32x4*)(src0 + (i * 64 + lane) * 4) : (f32x4){0.f, 0.f, 0.f, 0.f};
            v[1][i] = src1 ? *(const f32x4*)(src1 + (i * 64 + lane) * 4) : (f32x4){0.f, 0.f, 0.f, 0.f};
        }
#pragma unroll
        for (int i = 0; i < 4; ++i) {
            ss0 += v[0][i][0] * v[0][i][0] + v[0][i][1] * v[0][i][1] + v[0][i][2] * v[0][i][2] + v[0][i][3] * v[0][i][3];
            ss1 += v[1][i][0] * v[1][i][0] + v[1][i][1] * v[1][i][1] + v[1][i][2] * v[1][i][2] + v[1][i][3] * v[1][i][3];
        }
#pragma unroll
        for (int o = 32; o >= 1; o >>= 1) { ss0 += __shfl_xor(ss0, o); ss1 += __shfl_xor(ss1, o); }
        if (lane == 0) { rs[r] = rsqrtf(ss0 * (1.f / 1024.f) + EPS); rs[r + 1] = rsqrtf(ss1 * (1.f / 1024.f) + EPS); }
#pragma unroll
        for (int i = 0; i < 4; ++i) {
            u32x2 w0 = {pk2(v[0][i][0], v[0][i][1]), pk2(v[0][i][2], v[0][i][3])}; *(u32x2*)(xb + (size_t)r * 1024 + (i * 64 + lane) * 4) = w0;
            u32x2 w1 = {pk2(v[1][i][0], v[1][i][1]), pk2(v[1][i][2], v[1][i][3])}; *(u32x2*)(xb + (size_t)(r + 1) * 1024 + (i * 64 + lane) * 4) = w1;
        }
    }
    bf16_t* winT = (bf16_t*)(p.ws + W_WINT);
    for (int i = gtid; i < 2304 * 128; i += gsz) {
        const int n = i % 2304, k8 = i / 2304; float t[8];
        const int f = (n & ~255) + ((n >> 5) & 3) * 64 + ((n >> 7) & 1) * 32 + (n & 31);
#pragma unroll
        for (int j = 0; j < 8; ++j) t[j] = p.w_in[(size_t)(k8 * 8 + j) * 2304 + f] * p.norm_w[k8 * 8 + j];
        u32x4 w = {pk2(t[0], t[1]), pk2(t[2], t[3]), pk2(t[4], t[5]), pk2(t[6], t[7])};
        *(u32x4*)(winT + (size_t)n * 1024 + k8 * 8) = w;
    }
    {
        bf16_t* kF = (bf16_t*)(p.ws + W_KF); bf16_t* vF = (bf16_t*)(p.ws + W_VF);
        for (int i = gtid; i < 2 * 130 * 256; i += gsz) {
            const int piece = i & 255, s = (i >> 8) % 130, kvh = (i >> 8) / 130;
            const int blk = s < 2 ? s * 257 + 256 : 514 + (s - 2) * 5 + 4;
            const u32x4 z = {0u, 0u, 0u, 0u};
            *(u32x4*)(kF + (size_t)(kvh * NBLK + blk) * 2048 + piece * 8) = z;
            *(u32x4*)(vF + (size_t)(kvh * NBLK + blk) * 2048 + piece * 8) = z;
        }
    }
    float2* rope = (float2*)(p.ws + W_ROPE);
    for (int i = gtid; i < LP * 32; i += gsz) {
        const int pos = i >> 5, d = i & 31;
        const double inv = exp2(-(double)d * (13.287712379549449 / 32.0));
        double t = (double)pos * inv * 0.15915494309189535; t -= rint(t);
        const float r = (float)(t * 6.283185307179586);
        rope[i] = make_float2(cosf(r), sinf(r));
    }
}

DEVI void deferred_prep(const P& p, int gtid, int gsz) {
    bf16_t* wgT = (bf16_t*)(p.ws + W_WGLUT);
    for (int i = gtid; i < 512 * 64; i += gsz) {
        const int n = i % 512, k8 = i / 512; float t[8];
#pragma unroll
        for (int j = 0; j < 8; ++j) t[j] = p.w_glu[(size_t)(k8 * 8 + j) * 512 + n];
        u32x4 w = {pk2(t[0], t[1]), pk2(t[2], t[3]), pk2(t[4], t[5]), pk2(t[6], t[7])};
        *(u32x4*)(wgT + (size_t)n * 512 + k8 * 8) = w;
    }
    bf16_t* woT = (bf16_t*)(p.ws + W_WOUTT);
    for (int i = gtid; i < 1024 * 128; i += gsz) {
        const int n = i % 1024, k8 = i / 1024; float t[8];
#pragma unroll
        for (int j = 0; j < 8; ++j) { const int k = k8 * 8 + j; t[j] = p.w_out[(size_t)k * 1024 + n] * (k < 512 ? p.aon_w[k] : p.son_w[k - 512]); }
        u32x4 w = {pk2(t[0], t[1]), pk2(t[2], t[3]), pk2(t[4], t[5]), pk2(t[6], t[7])};
        *(u32x4*)(woT + (size_t)n * 1024 + k8 * 8) = w;
    }
    {
        bf16_t* kF = (bf16_t*)(p.ws + W_KF); bf16_t* vF = (bf16_t*)(p.ws + W_VF);
        for (int i = gtid; i < 2 * 128 * 4 * 4 * 64; i += gsz) {
            const int ln = i & 63, ks = (i >> 6) & 3, kb = (i >> 8) & 3, db = (i >> 10) & 127, kvh = i >> 17;
            const float* kp = p.cache_k + ((size_t)(db * 128 + kb * 32 + (ln & 31)) * 2 + kvh) * 64 + ks * 16 + (ln >> 5) * 8;
            const f32x4 a = *(const f32x4*)kp, c = *(const f32x4*)(kp + 4);
            u32x4 w = {pk2(a[0], a[1]), pk2(a[2], a[3]), pk2(c[0], c[1]), pk2(c[2], c[3])};
            *(u32x4*)(kF + ((size_t)((kvh * NBLK + 514 + db * 5 + kb) * 4 + ks) * 64 + ln) * 8) = w;
            const int db2 = ks >> 1, s2 = ks & 1, h = ln >> 5; float t[8];
#pragma unroll
            for (int j = 0; j < 8; ++j) { const int key = 16 * s2 + 8 * (j >> 2) + 4 * h + (j & 3);
                t[j] = p.cache_v[((size_t)(db * 128 + kb * 32 + key) * 2 + kvh) * 64 + db2 * 32 + (ln & 31)]; }
            u32x4 wv = {pk2(t[0], t[1]), pk2(t[2], t[3]), pk2(t[4], t[5]), pk2(t[6], t[7])};
            *(u32x4*)(vF + ((size_t)(((kvh * NBLK + 514 + db * 5 + kb) * 2 + db2) * 2 + s2) * 64 + ln) * 8) = wv;
        }
    }
    float2* lam = (float2*)(p.ws + W_LAM); float2* lam64 = (float2*)(p.ws + W_LAM64);
    bf16_t* bbarF = (bf16_t*)(p.ws + W_BBARF); bf16_t* cmF = (bf16_t*)(p.ws + W_CMF);
    for (int e = gsz - 1 - gtid; e < 32 * 64 * 16; e += gsz) {
        const int i = e >> 4, h = e & 15, g = i >> 6, n = i & 63;
        float fre, fim; float2 lv, l64v; p0_ssm_f(p, i, fre, fim, lv, l64v);
        if (h == 0) { lam[i] = lv; lam64[i] = l64v; }
        const float Br = p.B_re[(size_t)i * 16 + h], Bi = p.B_im[(size_t)i * 16 + h];
        const float bre = fre * Br - fim * Bi, bim = fre * Bi + fim * Br;
        const int cf0 = (n >= 32 ? 2 : 0), ln = (h >> 3) * 32 + (n & 31), j = h & 7;
        bbarF[((size_t)(g * 4 + cf0) * 64 + ln) * 8 + j] = f2bf(bre);
        bbarF[((size_t)(g * 4 + cf0 + 1) * 64 + ln) * 8 + j] = f2bf(bim);
        const int ho = h;
        const float cre = p.C_re[(size_t)(g * 16 + ho) * 64 + n], cim = p.C_im[(size_t)(g * 16 + ho) * 64 + n];
#pragma unroll
        for (int part = 0; part < 2; ++part) {
            const int kk = 2 * n + part, ks = kk >> 5, q = (kk & 31) >> 3, jj = kk & 7, ln2 = q * 16 + ho;
            cmF[((size_t)(g * 4 + ks) * 64 + ln2) * 8 + jj] = f2bf(part ? -cim : cre);
        }
    }
}

template <bool SAMPLE>
DEVI int attn_blk(int kb, int ia, int b, int q0) {
    if (SAMPLE) return 514 + ia * 5 + kb;
    int kpos0 = q0 - 128 + 32 * kb; kpos0 = kpos0 < 0 ? 0 : kpos0;
    return b * 257 + (kpos0 >> 5);
}
DEVI void attn_load_k(const P& p, int blk, int kvh, int lane, bf16x8 (&kfr)[4]) {
    const bf16_t* kF = (const bf16_t*)(p.ws + W_KF);
#pragma unroll
    for (int ks = 0; ks < 4; ++ks) kfr[ks] = *(const bf16x8*)(kF + ((size_t)((kvh * NBLK + blk) * 4 + ks) * 64 + lane) * 8);
}
DEVI void attn_load_v(const P& p, int blk, int kvh, int lane, bf16x8 (&vfr)[2][2]) {
    const bf16_t* vF = (const bf16_t*)(p.ws + W_VF);
#pragma unroll
    for (int db2 = 0; db2 < 2; ++db2)
#pragma unroll
        for (int s2 = 0; s2 < 2; ++s2) vfr[db2][s2] = *(const bf16x8*)(vF + ((size_t)(((kvh * NBLK + blk) * 2 + db2) * 2 + s2) * 64 + lane) * 8);
}

template <bool SAMPLE>
DEVI void attn_unit(const P& p, int ia, int ib, int ic) {
    const int lane = tidx() & 63, c5 = lane & 31, h = lane >> 5;
    const bf16_t* qb = (const bf16_t*)(p.ws + W_QB);
    int rowq, head, kvh, b = 0, q0 = 0; bool qok;
    if (SAMPLE) { const int db = ia; kvh = ib; head = kvh * 4 + (c5 & 3); rowq = NPR + db * 8 + (c5 >> 2); qok = true; }
    else { b = ia; head = ib; kvh = head >> 2; q0 = ic * 32; rowq = b * LP + q0 + c5; qok = (q0 + c5) < LP; }
    bf16x8 kfr[5][4], vfr[3][2][2];
#pragma unroll
    for (int kb = 0; kb < 5; ++kb) attn_load_k(p, attn_blk<SAMPLE>(kb, ia, b, q0), kvh, lane, kfr[kb]);
    bf16x8 qf[4];
#pragma unroll
    for (int ks = 0; ks < 4; ++ks) qf[ks] = *(const bf16x8*)(qb + (size_t)rowq * 512 + head * 64 + ks * 16 + h * 8);
#pragma unroll
    for (int kb = 0; kb < 3; ++kb) attn_load_v(p, attn_blk<SAMPLE>(kb, ia, b, q0), kvh, lane, vfr[kb]);
    float m = p.sinks[head] * LOG2E, lsum = h == 0 ? 1.f : 0.f;
    f32x16 O[2];
#pragma unroll
    for (int i = 0; i < 16; ++i) { O[0][i] = 0.f; O[1][i] = 0.f; }
    const int tq = SAMPLE ? (c5 >> 2) : c5;
    auto body = [&](int kb, const bf16x8 (&kf)[4], const bf16x8 (&vf)[2][2]) {
        const bool blk_ok = SAMPLE ? true : (q0 - 128 + 32 * kb) >= 0;
        f32x16 S;
#pragma unroll
        for (int i = 0; i < 16; ++i) S[i] = 0.f;
#pragma unroll
        for (int ks = 0; ks < 4; ++ks) S = mfma32(kf[ks], qf[ks], S);
        float mx = -3.0e38f;
#pragma unroll
        for (int i = 0; i < 16; ++i) {
            const int ki = (i & 3) + 8 * (i >> 2) + 4 * h;
            bool valid = blk_ok;
            if (kb == 0) valid = valid && (ki > tq); else if (kb == 4) valid = valid && (ki <= tq);
            S[i] = valid ? S[i] : -3.0e38f;
            mx = fmaxf(mx, S[i]);
        }
        mx = fmaxf(mx, __shfl_xor(mx, 32));
        const float mnew = fmaxf(m, mx), alpha = exp2f(m - mnew); m = mnew;
        float ps = 0.f; float pv[16];
#pragma unroll
        for (int i = 0; i < 16; ++i) { pv[i] = exp2f(S[i] - mnew); ps += pv[i]; }
        lsum = lsum * alpha + ps;
#pragma unroll
        for (int i = 0; i < 16; ++i) { O[0][i] *= alpha; O[1][i] *= alpha; }
        const bf16x8 pf0 = mk8(pk2(pv[0], pv[1]), pk2(pv[2], pv[3]), pk2(pv[4], pv[5]), pk2(pv[6], pv[7]));
        const bf16x8 pf1 = mk8(pk2(pv[8], pv[9]), pk2(pv[10], pv[11]), pk2(pv[12], pv[13]), pk2(pv[14], pv[15]));
#pragma unroll
        for (int db2 = 0; db2 < 2; ++db2) { O[db2] = mfma32(vf[db2][0], pf0, O[db2]); O[db2] = mfma32(vf[db2][1], pf1, O[db2]); }
    };
    body(0, kfr[0], vfr[0]);
    attn_load_v(p, attn_blk<SAMPLE>(3, ia, b, q0), kvh, lane, vfr[0]);
    body(1, kfr[1], vfr[1]);
    attn_load_v(p, attn_blk<SAMPLE>(4, ia, b, q0), kvh, lane, vfr[1]);
    body(2, kfr[2], vfr[2]);
    body(3, kfr[3], vfr[0]);
    body(4, kfr[4], vfr[1]);
    lsum += __shfl_xor(lsum, 32);
    const float inv = 1.f / lsum;
    const bf16_t* ga = (const bf16_t*)(p.ws + W_GA) + (size_t)rowq * 512 + head * 64;
    const int rowq3 = row3_of(rowq);
    bf16_t* ao = (bf16_t*)(p.ws + W_CAT) + (size_t)rowq3 * 1024 + head * 64;
    float ssq = 0.f;
#pragma unroll
    for (int db2 = 0; db2 < 2; ++db2)
#pragma unroll
        for (int a = 0; a < 4; ++a) {
            const int d0 = db2 * 32 + 8 * a + 4 * h;
            const u32x2 gw = qok ? *(const u32x2*)(ga + d0) : (u32x2){0u, 0u};
            const float g0 = bflo(gw[0]), g1 = bfhi(gw[0]), g2 = bflo(gw[1]), g3 = bfhi(gw[1]);
            const float o0 = O[db2][4 * a] * inv * silu_f(g0), o1 = O[db2][4 * a + 1] * inv * silu_f(g1), o2 = O[db2][4 * a + 2] * inv * silu_f(g2), o3 = O[db2][4 * a + 3] * inv * silu_f(g3);
            ssq += o0 * o0 + o1 * o1 + o2 * o2 + o3 * o3;
            if (qok) { u32x2 w = {pk2(o0, o1), pk2(o2, o3)}; *(u32x2*)(ao + d0) = w; }
        }
    ssq += __shfl_xor(ssq, 32);
    if (qok && h == 0) ((float*)(p.ws + W_SSQA))[(size_t)rowq3 * 8 + head] = ssq;
}

template <bool PASS2, bool FULLV = false>
DEVI void ssm_item(const P& p, char* wlds, bool sample, int ia, int g, int c) {
    const int lane = tidx() & 63, c5 = lane & 31, hh = lane >> 5;
    const bf16_t* uG = (const bf16_t*)(p.ws + W_UG) + (size_t)g * NROWS_PAD * 16;
    const float2* lamT = (const float2*)(p.ws + W_LAM) + g * 64; const float2* lam64T = (const float2*)(p.ws + W_LAM64) + g * 64;
    const float2 l0 = lamT[c5], l1 = lamT[32 + c5];
    int rowbase, nvalid, nrb;
    if (sample) { rowbase = NPR + (2 * ia + hh) * 8; nvalid = 8; nrb = 1; }
    else { const int pos0 = c * 128 + 64 * hh; rowbase = ia * LP + pos0; nvalid = LP - pos0; nvalid = nvalid < 0 ? 0 : (nvalid > 64 ? 64 : nvalid); nrb = c == 64 ? 1 : 4; }
    bf16x8 bfr[4];
#pragma unroll
    for (int cf = 0; cf < 4; ++cf) bfr[cf] = *(const bf16x8*)((const bf16_t*)(p.ws + W_BBARF) + ((size_t)(g * 4 + cf) * 64 + lane) * 8);
    const int ar_ = lane & 31, ahalf_ = (ar_ >> 2) & 1, aidx_ = (ar_ & 3) + 4 * (ar_ >> 3);
    u32x4 uall[4]; u32x2 dall[4][2];
    { int rbase_a, nv_a;
      if (sample) { rbase_a = NPR + (2 * ia + ahalf_) * 8; nv_a = 8; } else { const int pos0 = c * 128 + 64 * ahalf_; rbase_a = ia * LP + pos0; nv_a = LP - pos0; nv_a = nv_a < 0 ? 0 : (nv_a > 64 ? 64 : nv_a); }
#pragma unroll
      for (int rb = 0; rb < 4; ++rb) { const int ti = rb * 16 + aidx_; uall[rb] = (u32x4){0u, 0u, 0u, 0u};
          if (rb < nrb && ti < nv_a) uall[rb] = *(const u32x4*)(uG + (size_t)(rbase_a + ti) * 16 + (lane >> 5) * 8); }
      if (PASS2) {
#pragma unroll
          for (int tb = 0; tb < 2; ++tb) { int rb_base, nv_t;
              if (sample) { rb_base = NPR + (2 * ia + tb) * 8; nv_t = 8; } else { const int pos0 = c * 128 + 64 * tb; rb_base = ia * LP + pos0; nv_t = LP - pos0; nv_t = nv_t < 0 ? 0 : (nv_t > 64 ? 64 : nv_t); }
#pragma unroll
              for (int rb = 0; rb < 4; ++rb) { const int ti = rb * 16 + (lane & 15); dall[rb][tb] = (u32x2){0u, 0u};
                  if (rb < nrb && ti < nv_t) dall[rb][tb] = *(const u32x2*)(uG + (size_t)(rb_base + ti) * 16 + (lane >> 4) * 4); } }
      }
    }
    float x0r = 0.f, x0i = 0.f, x1r = 0.f, x1i = 0.f;
    if (PASS2) {
        if (sample) { const size_t o = ((size_t)(2 * ia + hh) * 32 + g) * 64; x0r = p.st_re[o + c5]; x0i = p.st_im[o + c5]; x1r = p.st_re[o + 32 + c5]; x1i = p.st_im[o + 32 + c5]; }
        else {
            int sc = 2 * c + hh; sc = sc > 128 ? 128 : sc;
            const float2* cy = (const float2*)(p.ws + W_CARRY) + ((size_t)(ia * 32 + g) * 129 + sc) * 64;
            const float2 c0 = cy[c5], c1 = cy[32 + c5];
            x0r = c0.x; x0i = c0.y; x1r = c1.x; x1i = c1.y;
        }
    }
    bf16x8 cfr[4];
    float dsk[4];
    if (PASS2) {
#pragma unroll
        for (int ks = 0; ks < 4; ++ks) cfr[ks] = *(const bf16x8*)((const bf16_t*)(p.ws + W_CMF) + ((size_t)(g * 4 + ks) * 64 + lane) * 8);
        const f32x4 d4 = *(const f32x4*)(p.Dk + g * 16 + (lane >> 4) * 4);
        dsk[0] = d4[0]; dsk[1] = d4[1]; dsk[2] = d4[2]; dsk[3] = d4[3];
    }
#pragma unroll
    for (int rb = 0; rb < 4; ++rb) {
        if (rb >= nrb) break;
        {
          const bf16x8 af = __builtin_bit_cast(bf16x8, uall[rb]);
          f32x16 bu[4];
#pragma unroll
          for (int cf = 0; cf < 4; ++cf) {
#pragma unroll
              for (int i = 0; i < 16; ++i) bu[cf][i] = 0.f;
              bu[cf] = mfma32(af, bfr[cf], bu[cf]);
          }
          const int nv_here = nvalid - rb * 16;
          unsigned* xw = (unsigned*)wlds;
#pragma unroll
          for (int i = 0; i < 16; ++i) {
              const float a = l0.x * x0r - l0.y * x0i + bu[0][i], bq = l0.x * x0i + l0.y * x0r + bu[1][i];
              const float cc = l1.x * x1r - l1.y * x1i + bu[2][i], dq = l1.x * x1i + l1.y * x1r + bu[3][i];
              if (PASS2 && !FULLV) { const bool v = i < nv_here; x0r = v ? a : x0r; x0i = v ? bq : x0i; x1r = v ? cc : x1r; x1i = v ? dq : x1i; }
              else { x0r = a; x0i = bq; x1r = cc; x1i = dq; }
              if (PASS2) { xw[(hh * 16 + i) * 68 + c5] = pk2(x0r, x0i); xw[(hh * 16 + i) * 68 + 32 + c5] = pk2(x1r, x1i); }
          }
        }
        if (PASS2) {
#pragma unroll
            for (int tb = 0; tb < 2; ++tb) {
                f32x4 y = {0.f, 0.f, 0.f, 0.f};
#pragma unroll
                for (int ks = 0; ks < 4; ++ks) {
                    const bf16x8 xf = *(const bf16x8*)(wlds + (tb * 16 + (lane & 15)) * 272 + ks * 64 + (lane >> 4) * 16);
                    y = mfma16(cfr[ks], xf, y);
                }
                int rb_base, nv_t;
                if (sample) { rb_base = NPR + (2 * ia + tb) * 8; nv_t = 8; } else { const int pos0 = c * 128 + 64 * tb; rb_base = ia * LP + pos0; nv_t = LP - pos0; nv_t = nv_t < 0 ? 0 : (nv_t > 64 ? 64 : nv_t); }
                const int ti = rb * 16 + (lane & 15);
                if (ti < nv_t) {
                    const int row = rb_base + ti;
                    const u32x2 uw = dall[rb][tb];
                    const float y0 = y[0] + dsk[0] * bflo(uw[0]), y1 = y[1] + dsk[1] * bfhi(uw[0]), y2 = y[2] + dsk[2] * bflo(uw[1]), y3 = y[3] + dsk[3] * bfhi(uw[1]);
                    u32x2 w = {pk2(gelu_tanh(y0), gelu_tanh(y1)), pk2(gelu_tanh(y2), gelu_tanh(y3))};
                    *(u32x2*)(gb_base(p.ws, sample) + (size_t)row3_of(row) * 512 + g * 16 + (lane >> 4) * 4) = w;
                }
            }
        }
    }
    if (!PASS2) {
        float2* ends = (float2*)(p.ws + W_ENDS) + (size_t)(ia * 32 + g) * 128 * 64 + (size_t)(2 * c + hh) * 64;
        ends[c5] = make_float2(x0r, x0i); ends[32 + c5] = make_float2(x1r, x1i);
    } else {
        if (sample) { const size_t o = ((size_t)(2 * ia + hh) * 32 + g) * 64;
            p.out[O_SRS + o + c5] = x0r; p.out[O_SIS + o + c5] = x0i; p.out[O_SRS + o + 32 + c5] = x1r; p.out[O_SIS + o + 32 + c5] = x1i; }
        else if (c == 64 && hh == 0) { const size_t o = ((size_t)ia * 32 + g) * 64;
            p.out[O_SRP + o + c5] = x0r; p.out[O_SIP + o + c5] = x0i; p.out[O_SRP + o + 32 + c5] = x1r; p.out[O_SIP + o + 32 + c5] = x1i; }
    }
}

DEVI void phase2a(const P& p, char* lds) {
    const int tid = tidx(), wid = tid >> 6, lane = tid & 63;
    if (blockIdx.x < 64) {
        const int bg = blockIdx.x, g = bg & 31, b = bg >> 5;
#pragma unroll 1
        for (int k = 0; k < 8; ++k) ssm_item<false>(p, lds + wid * 8704, false, b, g, wid * 8 + k);
        asm volatile("s_waitcnt vmcnt(0)" ::: "memory");
        __syncthreads();
        const float2 L = ((const float2*)(p.ws + W_LAM64))[g * 64 + lane];
        const float2* ends = (const float2*)(p.ws + W_ENDS) + (size_t)bg * 128 * 64 + (size_t)(16 * wid) * 64 + lane;
        float2 e[16];
#pragma unroll
        for (int s = 0; s < 16; ++s) e[s] = ends[s * 64];
        float xr = 0.f, xi = 0.f;
#pragma unroll
        for (int s = 0; s < 16; ++s) { const float a = L.x * xr - L.y * xi + e[s].x, bq = L.x * xi + L.y * xr + e[s].y; xr = a; xi = bq; }
        float pr = L.x, pi = L.y;
#pragma unroll
        for (int k = 0; k < 4; ++k) { const float a = pr * pr - pi * pi, bq = 2.f * pr * pi; pr = a; pi = bq; }
        float2* seg = (float2*)lds;
        seg[wid * 64 + lane] = make_float2(xr, xi);
        __syncthreads();
        float cr = 0.f, ci = 0.f;
        for (int i = 0; i < wid; ++i) { const float2 q = seg[i * 64 + lane]; const float a = pr * cr - pi * ci + q.x, bq = pr * ci + pi * cr + q.y; cr = a; ci = bq; }
        float2* cy = (float2*)(p.ws + W_CARRY) + (size_t)bg * 129 * 64 + (size_t)(16 * wid) * 64 + lane;
        xr = cr; xi = ci;
#pragma unroll
        for (int s = 0; s < 16; ++s) { cy[s * 64] = make_float2(xr, xi); const float a = L.x * xr - L.y * xi + e[s].x, bq = L.x * xi + L.y * xr + e[s].y; xr = a; xi = bq; }
        if (wid == 7) cy[16 * 64] = make_float2(xr, xi);
        __syncthreads();
    } else {
        const int vb0 = (int)blockIdx.x - 64;
        const int w = ((vb0 & 7) * 24 + (vb0 >> 3)) * 8 + wid;
        for (int u = w; u < 4096; u += 1536) { const int head = u & 7, r = u >> 3, qblk = r & 255, b = r >> 8; attn_unit<false>(p, b, head, qblk); }
        { const int e = w - 1024; if (e >= 0 && e < 16) attn_unit<false>(p, e >> 3, e & 7, 256); }
        { const int s = w - 1024 - 16; if (s >= 0 && s < 256) attn_unit<true>(p, s >> 1, s & 1, 0); }
        if (w < 1296) ssm_item<true>(p, lds + wid * 8704, true, w >> 5, w & 31, 0);
        else for (int u = w; u < 2048; u += 240) ssm_item<true>(p, lds + wid * 8704, true, u >> 5, u & 31, 0);
    }
}
DEVI void phase2b(const P& p, char* lds) {
    const int wid = tidx() >> 6;
    for (int k = 0; k < 2; ++k) { const int it = blockIdx.x * 8 + wid + k * 1856; const int c = it & 63, g = (it >> 6) & 31, b = it >> 11; ssm_item<true, true>(p, lds + wid * 8704, false, b, g, c); }
    if (wid < 2) { const int j = wid * 232 + (int)blockIdx.x; if (j < 384) { const int it = 3712 + j; const int c = it & 63, g = (it >> 6) & 31, b = it >> 11; ssm_item<true, true>(p, lds + wid * 8704, false, b, g, c); } }
    for (int it = (231 - (int)blockIdx.x) * 8 + wid; it < 64; it += 232 * 8) ssm_item<true, false>(p, lds + wid * 8704, false, it >> 5, it & 31, 64);
}

namespace pg8 {
#define PG8_LAS __attribute__((address_space(3)))
constexpr int BM = 256, BK = 64, HALF = 128, HTB = HALF * BK * 2  , STAGE_BYTES = 8 * HTB, NXCD = 8, WGM = 8;
__host__ __device__ __forceinline__ int lds_byte(int r, int c) { const int st = (r >> 4) * 2 + (c >> 5), rr = r & 15, cc = c & 31, ob = rr * 64 + cc * 2; return st * 1024 + (ob ^ (((ob >> 9) & 1) << 5)); }
__host__ __device__ __forceinline__ void stage_rc(int b, int& R, int& C) { const int st = b / 1024, sb = b % 1024, swz = sb ^ (((sb >> 9) & 1) << 5); R = (st >> 1) * 16 + swz / 64; C = (st & 1) * 32 + (swz % 64) / 2; }
__host__ __device__ __forceinline__ int perm32(int rho) { const int n = rho >> 4, i = rho & 15; return 8 * (i >> 2) + 4 * n + (i & 3); }
struct Unit { int pm, pn; };
struct Gemm { const bf16_t* A; const bf16_t* Bt; int lda, ldb, K; };
struct StaticOrder {
    int nM, nN, nwg, G, c;
    __host__ __device__ void init(int M, int N, int G_, int c_) { nM = M / BM; nN = N / BM; nwg = nM * nN; G = G_; c = c_; }
    __host__ __device__ bool next(int i, Unit& u) const {
        const long L = (long)i * G + c; if (L >= nwg) return false;
        int wgid = (int)L; { const int q = nwg / NXCD, r = nwg % NXCD, xcd = wgid % NXCD, off = wgid / NXCD; wgid = (xcd < r ? xcd * (q + 1) : r * (q + 1) + (xcd - r) * q) + off; }
        const int nig = WGM * nN, gid = wgid / nig, fm = gid * WGM, gsz = (nM - fm) < WGM ? (nM - fm) : WGM;
        u.pm = fm + ((wgid % nig) % gsz); u.pn = (wgid % nig) / gsz; return true;
    }
};
template <class Epi, class Sched>
__device__ __forceinline__ void gemm_phase(PG8_LAS unsigned char* lds, const Gemm g, const Sched& S, const Epi& E) {
    const int tid = tidx(), wid = __builtin_amdgcn_readfirstlane(tid >> 6), lane = tid & 63, wr = wid >> 2, wc = wid & 3, fr = lane & 15, fq = lane >> 4;
    const int K = g.K, nt = K / BK;
    unsigned voffA[2], voffB[2];
#pragma unroll
    for (int i = 0; i < 2; ++i) { int R, C; stage_rc(tid * 16 + i * 8192, R, C); const int Rb = (R & ~31) + perm32(R & 31); voffA[i] = (unsigned)(R * g.lda + C) * 2u; voffB[i] = (unsigned)(Rb * g.ldb + C) * 2u; }
    const size_t kstep = (size_t)(BK * 2);
    const size_t hstepA = (size_t)HALF * g.lda * 2, hstepB = (size_t)HALF * g.ldb * 2;
    const size_t tstepA = 2 * hstepA, tstepB = 2 * hstepB;
    const unsigned ldsw = (unsigned)wid * 1024u;
    const int aoff = lds_byte(wr * 64 + fr, fq * 8), boff = lds_byte(wc * 32 + fr, fq * 8);
#define PG8_SA(b, h) (((b) * 2 + (h)) * HTB)
#define PG8_SB(b, h) ((4 + (b) * 2 + (h)) * HTB)
#define PG8_STAGE(bufoff, gbase, voff) do { _Pragma("unroll") for (int _i = 0; _i < 2; ++_i) \
        __builtin_amdgcn_global_load_lds((const unsigned*)((const char*)(gbase) + (voff)[_i]), (PG8_LAS unsigned*)(lds + (bufoff) + ldsw + _i * 8192), 16, 0, 0); } while (0)
#define PG8_LDA(dst, b, h) do { _Pragma("unroll") for (int m = 0; m < 4; ++m) _Pragma("unroll") for (int k = 0; k < 2; ++k) dst[m][k] = *(const PG8_LAS bf16x8*)(lds + PG8_SA(b, h) + aoff + m * 2048 + k * 1024); } while (0)
#define PG8_LDB(dst, b, h) do { _Pragma("unroll") for (int n = 0; n < 2; ++n) _Pragma("unroll") for (int k = 0; k < 2; ++k) dst[n][k] = *(const PG8_LAS bf16x8*)(lds + PG8_SB(b, h) + boff + n * 2048 + k * 1024); } while (0)
#define PG8_MMA(ai, bj, At, Bt) do { __builtin_amdgcn_s_setprio(1); _Pragma("unroll") for (int m = 0; m < 4; ++m) _Pragma("unroll") for (int n = 0; n < 2; ++n) _Pragma("unroll") for (int k = 0; k < 2; ++k) \
        acc[ai][bj][m][n] = __builtin_amdgcn_mfma_f32_16x16x32_bf16(Bt[n][k], At[m][k], acc[ai][bj][m][n], 0, 0, 0); __builtin_amdgcn_s_setprio(0); } while (0)
#define PG8_WAIT_V(n) asm volatile("s_waitcnt vmcnt(" #n ")" ::: "memory")
#define PG8_WAIT_L(n) asm volatile("s_waitcnt lgkmcnt(" #n ")" ::: "memory")
#define PG8_BAR __builtin_amdgcn_s_barrier()
#define PG8_SCHED __builtin_amdgcn_sched_barrier(0)
    Unit cur, nxt; int ui = 0;
    if (!S.next(0, cur)) return;
    f32x4 acc[2][2][4][2];
#pragma unroll
    for (int a = 0; a < 2; ++a)
#pragma unroll
        for (int b = 0; b < 2; ++b)
#pragma unroll
            for (int m = 0; m < 4; ++m)
#pragma unroll
                for (int n = 0; n < 2; ++n) acc[a][b][m][n] = (f32x4){0.f, 0.f, 0.f, 0.f};
    bf16x8 At[4][2], B0[2][2], B1[2][2];
    const char* cA = (const char*)g.A + (size_t)cur.pm * tstepA; const char* cB = (const char*)g.Bt + (size_t)cur.pn * tstepB;
    E.begin(cur, 0, tid, lds);
    asm volatile("s_waitcnt vmcnt(0) lgkmcnt(0)" ::: "memory");
    PG8_BAR;
    PG8_STAGE(PG8_SB(0, 0), cB, voffB); PG8_STAGE(PG8_SB(0, 1), cB + hstepB, voffB); PG8_STAGE(PG8_SA(0, 0), cA, voffA); PG8_STAGE(PG8_SA(0, 1), cA + hstepA, voffA);
    if (wr == 1) PG8_BAR;
    PG8_WAIT_V(2); PG8_BAR;
    PG8_STAGE(PG8_SB(1, 0), cB + kstep, voffB); PG8_STAGE(PG8_SA(1, 0), cA + kstep, voffA); PG8_STAGE(PG8_SB(1, 1), cB + hstepB + kstep, voffB);
    PG8_WAIT_V(6); PG8_BAR;
    for (;;) {
        const bool has_next = S.next(ui + 1, nxt);
        const char* nA = has_next ? (const char*)g.A + (size_t)nxt.pm * tstepA : cA; const char* nB = has_next ? (const char*)g.Bt + (size_t)nxt.pn * tstepB : cB;
        for (int t = 0; t < nt; t += 2) {
            const bool last = (t == nt - 2);
            const char* a1 = cA + (size_t)(t + 1) * kstep;
            const char* a2 = last ? nA : cA + (size_t)(t + 2) * kstep; const char* b2 = last ? nB : cB + (size_t)(t + 2) * kstep;
            const char* a3 = a2 + kstep; const char* b3 = b2 + kstep;
            if constexpr (Epi::HAS_MID) { if (t == nt / 2) E.mid(acc, wr, fr, ui, lds); }
            PG8_LDB(B0, 0, 0); PG8_LDB(B1, 0, 1); PG8_SCHED; PG8_LDA(At, 0, 0); PG8_STAGE(PG8_SA(1, 1), a1 + hstepA, voffA);
            PG8_WAIT_V(8); PG8_WAIT_L(0); PG8_BAR; PG8_MMA(0, 0, At, B0); PG8_MMA(0, 1, At, B1); PG8_BAR; PG8_SCHED;
            PG8_LDA(At, 0, 1); PG8_STAGE(PG8_SB(0, 0), b2, voffB); PG8_STAGE(PG8_SB(0, 1), b2 + hstepB, voffB); PG8_STAGE(PG8_SA(0, 0), a2, voffA);
            PG8_WAIT_V(8); PG8_WAIT_L(0); PG8_BAR; PG8_MMA(1, 0, At, B0); PG8_MMA(1, 1, At, B1); PG8_BAR; PG8_SCHED;
            PG8_LDB(B0, 1, 0); PG8_LDB(B1, 1, 1); PG8_SCHED; PG8_LDA(At, 1, 0); PG8_STAGE(PG8_SA(0, 1), a2 + hstepA, voffA);
            PG8_WAIT_V(8); PG8_WAIT_L(0); PG8_BAR; PG8_MMA(0, 0, At, B0); PG8_MMA(0, 1, At, B1); PG8_BAR; PG8_SCHED;
            PG8_LDA(At, 1, 1); PG8_STAGE(PG8_SB(1, 0), b3, voffB); PG8_STAGE(PG8_SB(1, 1), b3 + hstepB, voffB); PG8_STAGE(PG8_SA(1, 0), a3, voffA);
            PG8_WAIT_V(8); PG8_WAIT_L(0); PG8_BAR; PG8_MMA(1, 0, At, B0); PG8_MMA(1, 1, At, B1); PG8_BAR; PG8_SCHED;
        }
        if (wr == 0) PG8_BAR;
        E(acc, cur, wr, wc, fr, fq, ui, lds);
        if (!has_next) break;
#pragma unroll
        for (int a = 0; a < 2; ++a)
#pragma unroll
            for (int b = 0; b < 2; ++b)
#pragma unroll
                for (int m = 0; m < 4; ++m)
#pragma unroll
                    for (int n = 0; n < 2; ++n) acc[a][b][m][n] = (f32x4){0.f, 0.f, 0.f, 0.f};
        cur = nxt; cA = nA; cB = nB; ++ui;
        E.begin(cur, ui, tid, lds);
        if (wr == 1) PG8_BAR;
    }
    PG8_WAIT_V(0);
    PG8_BAR;
#undef PG8_SA
#undef PG8_SB
#undef PG8_STAGE
#undef PG8_LDA
#undef PG8_LDB
#undef PG8_MMA
#undef PG8_WAIT_V
#undef PG8_WAIT_L
#undef PG8_BAR
#undef PG8_SCHED
}
}

typedef const f32x4 (&AccRef)[2][2][4][2];

struct EpiP1 {
    static constexpr bool HAS_MID = false;
    P p;
    DEVI void begin(const pg8::Unit&, int, int, PG8_LAS unsigned char*) const {}
    DEVI void mid(f32x4 (&)[2][2][4][2], int, int, int, PG8_LAS unsigned char*) const {}
    DEVI void operator()(AccRef acc, const pg8::Unit& u, int wr, int wc, int fr, int fq, int, PG8_LAS unsigned char*) const {
        const float* rs = (const float*)(p.ws + W_RS);
        const int pn = u.pn;
        const int kind = pn < 2 ? 0 : (pn == 2 ? (wc < 2 ? 1 : 2) : (pn < 5 ? 3 : (pn < 7 ? 4 : 5)));
        if (kind <= 1) {
            const float* nw = kind == 0 ? p.q_norm_w : p.k_norm_w;
            f32x4 w4[2][2];
#pragma unroll
            for (int bj = 0; bj < 2; ++bj)
#pragma unroll
                for (int n = 0; n < 2; ++n) w4[bj][n] = *(const f32x4*)(nw + 32 * bj + 8 * fq + 4 * n);
            const float2* rope = (const float2*)(p.ws + W_ROPE);
#pragma unroll
            for (int ai = 0; ai < 2; ++ai)
#pragma unroll
                for (int m = 0; m < 4; ++m) {
                    const int row = u.pm * 256 + ai * 128 + wr * 64 + m * 16 + fr;
                    const float rsv = rs[row];
                    const bool isp = row < NPR; const int b = row >= LP ? 1 : 0;
                    const int pos = isp ? row - b * LP : 8192 + ((row - NPR) & 7);
                    float v[2][2][4]; float ss = 0.f;
#pragma unroll
                    for (int bj = 0; bj < 2; ++bj)
#pragma unroll
                        for (int n = 0; n < 2; ++n)
#pragma unroll
                            for (int j = 0; j < 4; ++j) { v[bj][n][j] = acc[ai][bj][m][n][j] * rsv; ss += v[bj][n][j] * v[bj][n][j]; }
                    ss += __shfl_xor(ss, 16); ss += __shfl_xor(ss, 32);
                    const float rinv = rsqrtf(ss * (1.f / 64.f) + EPS);
                    const int rpos = pos < LP ? pos : LP - 1;
#pragma unroll
                    for (int n = 0; n < 2; ++n) {
                        const f32x4 cs0 = *(const f32x4*)(rope + (size_t)rpos * 32 + 8 * fq + 4 * n);
                        const f32x4 cs1 = *(const f32x4*)(rope + (size_t)rpos * 32 + 8 * fq + 4 * n + 2);
                        const float c[4] = {cs0[0], cs0[2], cs1[0], cs1[2]}, s[4] = {cs0[1], cs0[3], cs1[1], cs1[3]};
#pragma unroll
                        for (int j = 0; j < 4; ++j) { const float x1 = v[0][n][j] * rinv * w4[0][n][j], x2 = v[1][n][j] * rinv * w4[1][n][j];
                            v[0][n][j] = x1 * c[j] - x2 * s[j]; v[1][n][j] = x2 * c[j] + x1 * s[j]; }
                    }
                    if (kind == 0) {
                        if (row < NROWS) { bf16_t* qb = (bf16_t*)(p.ws + W_QB) + (size_t)row * 512 + (pn * 4 + wc) * 64 + 8 * fq;
#pragma unroll
                            for (int bj = 0; bj < 2; ++bj) { u32x4 w = {pk2(v[bj][0][0] * QSCALE, v[bj][0][1] * QSCALE), pk2(v[bj][0][2] * QSCALE, v[bj][0][3] * QSCALE), pk2(v[bj][1][0] * QSCALE, v[bj][1][1] * QSCALE), pk2(v[bj][1][2] * QSCALE, v[bj][1][3] * QSCALE)};
                                *(u32x4*)(qb + 32 * bj) = w; } }
                    } else {
                        const int kvh = wc;
                        if (row < NROWS) {
                            const int blk = isp ? b * 257 + (pos >> 5) : 514 + ((row - NPR) >> 3) * 5 + 4, key = isp ? (pos & 31) : ((row - NPR) & 7);
                            bf16_t* kF = (bf16_t*)(p.ws + W_KF);
#pragma unroll
                            for (int bj = 0; bj < 2; ++bj) { u32x4 w = {pk2(v[bj][0][0], v[bj][0][1]), pk2(v[bj][0][2], v[bj][0][3]), pk2(v[bj][1][0], v[bj][1][1]), pk2(v[bj][1][2], v[bj][1][3])};
                                *(u32x4*)(kF + ((size_t)((kvh * NBLK + blk) * 4 + 2 * bj + (fq >> 1)) * 64 + (fq & 1) * 32 + key) * 8) = w; }
                        }
                        if (isp) {
                            if (pos >= LP - 128) { float* o = p.out + O_KWP + ((size_t)(b * 128 + pos - (LP - 128)) * 2 + kvh) * 64 + 8 * fq;
#pragma unroll
                                for (int bj = 0; bj < 2; ++bj)
#pragma unroll
                                    for (int n = 0; n < 2; ++n) *(f32x4*)(o + 32 * bj + 4 * n) = (f32x4){v[bj][n][0], v[bj][n][1], v[bj][n][2], v[bj][n][3]}; }
                        } else if (row < NROWS) { float* o = p.out + O_KNS + ((size_t)(row - NPR) * 2 + kvh) * 64 + 8 * fq;
#pragma unroll
                            for (int bj = 0; bj < 2; ++bj)
#pragma unroll
                                for (int n = 0; n < 2; ++n) *(f32x4*)(o + 32 * bj + 4 * n) = (f32x4){v[bj][n][0], v[bj][n][1], v[bj][n][2], v[bj][n][3]}; }
                    }
                    asm volatile("" ::: "memory");
                }
        } else if (kind == 2) {
            const int kvh = wc - 2;
#pragma unroll
            for (int ai = 0; ai < 2; ++ai)
#pragma unroll
                for (int m = 0; m < 4; ++m) {
                    const int row = u.pm * 256 + ai * 128 + wr * 64 + m * 16 + fr;
                    const float rsv = rs[row];
                    const bool isp = row < NPR; const int b = row >= LP ? 1 : 0;
                    const int pos = isp ? row - b * LP : 0;
                    if (row < NROWS) {
                        const int blk = isp ? b * 257 + (pos >> 5) : 514 + ((row - NPR) >> 3) * 5 + 4, kk = isp ? (pos & 31) : ((row - NPR) & 7), s2 = kk >> 4, r16 = kk & 15, jj = (r16 >> 3) * 4 + (r16 & 3), hh = (r16 >> 2) & 1;
                        bf16_t* vF = (bf16_t*)(p.ws + W_VF);
#pragma unroll
                        for (int bj = 0; bj < 2; ++bj)
#pragma unroll
                            for (int n = 0; n < 2; ++n)
#pragma unroll
                                for (int j = 0; j < 4; ++j)
                                    vF[((size_t)(((kvh * NBLK + blk) * 2 + bj) * 2 + s2) * 64 + hh * 32 + (8 * fq + 4 * n + j)) * 8 + jj] = f2bf(acc[ai][bj][m][n][j] * rsv);
                    }
                    if (isp) {
                        if (pos >= LP - 128) { float* o = p.out + O_VWP + ((size_t)(b * 128 + pos - (LP - 128)) * 2 + kvh) * 64 + 8 * fq;
#pragma unroll
                            for (int bj = 0; bj < 2; ++bj)
#pragma unroll
                                for (int n = 0; n < 2; ++n) *(f32x4*)(o + 32 * bj + 4 * n) = acc[ai][bj][m][n] * rsv; }
                    } else if (row < NROWS) { float* o = p.out + O_VNS + ((size_t)(row - NPR) * 2 + kvh) * 64 + 8 * fq;
#pragma unroll
                        for (int bj = 0; bj < 2; ++bj)
#pragma unroll
                            for (int n = 0; n < 2; ++n) *(f32x4*)(o + 32 * bj + 4 * n) = acc[ai][bj][m][n] * rsv; }
                    asm volatile("" ::: "memory");
                }
        } else if (kind == 4) {
            bf16_t* uG = (bf16_t*)(p.ws + W_UG);
#pragma unroll
            for (int ai = 0; ai < 2; ++ai)
#pragma unroll
                for (int m = 0; m < 4; ++m) {
                    const int row = u.pm * 256 + ai * 128 + wr * 64 + m * 16 + fr;
                    const float rsv = rs[row];
                    if (row < NROWS) {
#pragma unroll
                        for (int bj = 0; bj < 2; ++bj) { const int g = (pn - 5) * 16 + 4 * wc + 2 * bj + (fq >> 1); const f32x4 t0 = acc[ai][bj][m][0] * rsv, t1 = acc[ai][bj][m][1] * rsv;
                            u32x4 w = {pk2(t0[0], t0[1]), pk2(t0[2], t0[3]), pk2(t1[0], t1[1]), pk2(t1[2], t1[3])}; *(u32x4*)(uG + ((size_t)g * NROWS_PAD + row) * 16 + 8 * (fq & 1)) = w; }
                    }
                }
        } else {
            bf16_t* dst0 = (bf16_t*)(p.ws + (kind == 3 ? W_GA : W_GS)) + (kind == 3 ? pn - 3 : pn - 7) * 256 + 64 * wc + 8 * fq;
#pragma unroll
            for (int ai = 0; ai < 2; ++ai)
#pragma unroll
                for (int m = 0; m < 4; ++m) {
                    const int row = u.pm * 256 + ai * 128 + wr * 64 + m * 16 + fr;
                    const float rsv = rs[row];
                    if (row < NROWS) {
                        const int rowd = kind == 3 ? row : row3_of(row);
#pragma unroll
                        for (int bj = 0; bj < 2; ++bj) { const f32x4 t0 = acc[ai][bj][m][0] * rsv, t1 = acc[ai][bj][m][1] * rsv;
                            u32x4 w = {pk2(t0[0], t0[1]), pk2(t0[2], t0[3]), pk2(t1[0], t1[1]), pk2(t1[2], t1[3])}; *(u32x4*)(dst0 + (size_t)rowd * 512 + 32 * bj) = w; }
                    }
                }
        }
    }
};

struct EpiGlu {
    static constexpr bool HAS_MID = false;
    P p;
    DEVI void begin(const pg8::Unit&, int, int, PG8_LAS unsigned char*) const {}
    DEVI void mid(f32x4 (&)[2][2][4][2], int, int, int, PG8_LAS unsigned char*) const {}
    DEVI void operator()(AccRef acc, const pg8::Unit& u, int wr, int wc, int fr, int fq, int, PG8_LAS unsigned char*) const {
        const bf16_t* gB = gb_base(p.ws, u.pm >= 64); const bf16_t* gs = (const bf16_t*)(p.ws + W_GS);
        bf16_t* cat = (bf16_t*)(p.ws + W_CAT); float* ssqs = (float*)(p.ws + W_SSQS);
        const int f0 = u.pn * 256 + 32 * wc + 8 * fq;
        f32x4 bg[2][2];
#pragma unroll
        for (int bj = 0; bj < 2; ++bj)
#pragma unroll
            for (int n = 0; n < 2; ++n) bg[bj][n] = *(const f32x4*)(p.b_glu + f0 + 128 * bj + 4 * n);
#pragma unroll
        for (int ai = 0; ai < 2; ++ai)
#pragma unroll
            for (int m = 0; m < 4; ++m) {
                const int row = u.pm * 256 + ai * 128 + wr * 64 + m * 16 + fr;
                float ssq = 0.f;
#pragma unroll
                for (int bj = 0; bj < 2; ++bj) {
                    const int f = f0 + 128 * bj;
                    const u32x4 gw = *(const u32x4*)(gB + (size_t)row * 512 + f), sw = *(const u32x4*)(gs + (size_t)row * 512 + f);
                    float s[8];
#pragma unroll
                    for (int n = 0; n < 2; ++n)
#pragma unroll
                        for (int j = 0; j < 4; ++j) { const unsigned gwd = gw[2 * n + (j >> 1)], swd = sw[2 * n + (j >> 1)];
                            const float gl = (j & 1) ? bfhi(gwd) : bflo(gwd), gv = (j & 1) ? bfhi(swd) : bflo(swd);
                            s[4 * n + j] = gl * sigmoid_f(acc[ai][bj][m][n][j] + bg[bj][n][j]) * silu_f(gv); ssq += s[4 * n + j] * s[4 * n + j]; }
                    { u32x4 w = {pk2(s[0], s[1]), pk2(s[2], s[3]), pk2(s[4], s[5]), pk2(s[6], s[7])}; *(u32x4*)(cat + (size_t)row * 1024 + 512 + f) = w; }
                }
                ssq += __shfl_xor(ssq, 16); ssq += __shfl_xor(ssq, 32);
                if (fq == 0) ssqs[(size_t)row * 8 + u.pn * 4 + wc] = ssq;
                asm volatile("" ::: "memory");
            }
    }
};

constexpr int LDS_TAB = 131072;
struct EpiOut {
    static constexpr bool HAS_MID = true;
    P p;
    DEVI void begin(const pg8::Unit& u, int ui, int tid, PG8_LAS unsigned char* lds) const {
        if (tid < 256) {
            const int row = u.pm * 256 + tid;
            float ra = 1.f, rsv = 1.f;
            {
                const float* ssqa = (const float*)(p.ws + W_SSQA) + (size_t)row * 8; const float* ssqs = (const float*)(p.ws + W_SSQS) + (size_t)row * 8;
                const f32x4 a0 = *(const f32x4*)(ssqa), a1 = *(const f32x4*)(ssqa + 4), s0 = *(const f32x4*)(ssqs), s1 = *(const f32x4*)(ssqs + 4);
                ra = rsqrtf(((a0[0] + a0[1]) + (a0[2] + a0[3]) + (a1[0] + a1[1]) + (a1[2] + a1[3])) * (1.f / 512.f) + EPS);
                rsv = rsqrtf(((s0[0] + s0[1]) + (s0[2] + s0[3]) + (s1[0] + s1[1]) + (s1[2] + s1[3])) * (1.f / 512.f) + EPS);
            }
            ((PG8_LAS f32x2*)(lds + LDS_TAB))[(ui & 1) * 256 + tid] = (f32x2){ra / rsv, rsv};
        }
    }
    DEVI void mid(f32x4 (&acc)[2][2][4][2], int wr, int fr, int ui, PG8_LAS unsigned char* lds) const {
#pragma unroll
        for (int ai = 0; ai < 2; ++ai)
#pragma unroll
            for (int m = 0; m < 4; ++m) {
                const float sc = ((const PG8_LAS f32x2*)(lds + LDS_TAB))[(ui & 1) * 256 + ai * 128 + wr * 64 + m * 16 + fr].x;
#pragma unroll
                for (int bj = 0; bj < 2; ++bj)
#pragma unroll
                    for (int n = 0; n < 2; ++n) acc[ai][bj][m][n] *= sc;
            }
    }
    DEVI void operator()(AccRef acc, const pg8::Unit& u, int wr, int wc, int fr, int fq, int ui, PG8_LAS unsigned char* lds) const {
#pragma unroll
        for (int ai = 0; ai < 2; ++ai)
#pragma unroll
            for (int m = 0; m < 4; ++m) {
                const int rl = ai * 128 + wr * 64 + m * 16 + fr, row = u.pm * 256 + rl;
                const float rsv = ((const PG8_LAS f32x2*)(lds + LDS_TAB))[(ui & 1) * 256 + rl].y;
                const float* xr; float* yo;
                if (row < 16384) { const size_t o = (size_t)row * 1024; xr = p.x_prompt + o; yo = p.out + O_YP + o; }
                else { const size_t o = (size_t)(row - 16384) * 1024; xr = p.x_sample + o; yo = p.out + O_YS + o; }
                {
#pragma unroll
                    for (int bj = 0; bj < 2; ++bj)
#pragma unroll
                        for (int n = 0; n < 2; ++n) { const int f = u.pn * 256 + 128 * bj + 32 * wc + 8 * fq + 4 * n;
                            const f32x4 xv = *(const f32x4*)(xr + f); *(f32x4*)(yo + f) = xv + acc[ai][bj][m][n] * rsv; }
                }
                asm volatile("" ::: "memory");
            }
    }
};

DEVI void phase1(const P& p, PG8_LAS unsigned char* lds) {
    pg8::Gemm g{(const bf16_t*)(p.ws + W_XB), (const bf16_t*)(p.ws + W_WINT), 1024, 1024, 1024};
    pg8::StaticOrder S; S.init(NROWS_PAD, 2304, gridDim.x, blockIdx.x);
    EpiP1 E{p};
    pg8::gemm_phase<EpiP1, pg8::StaticOrder>(lds, g, S, E);
    const int n3 = 621 - 2 * (int)gridDim.x;
    if ((int)blockIdx.x >= n3) deferred_prep(p, ((int)blockIdx.x - n3) * 512 + tidx(), ((int)gridDim.x - n3) * 512);
}
template <bool FIRST>
struct EpiOutHalf {
    static constexpr bool HAS_MID = false;
    P p;
    DEVI void begin(const pg8::Unit& u, int ui, int tid, PG8_LAS unsigned char* lds) const {
        if (tid < 256) {
            const int row = u.pm * 256 + tid;
            const float* ssq = (const float*)(p.ws + (FIRST ? W_SSQA : W_SSQS)) + (size_t)row * 8;
            const f32x4 a0 = *(const f32x4*)(ssq), a1 = *(const f32x4*)(ssq + 4);
            ((PG8_LAS float*)(lds + LDS_TAB))[(ui & 1) * 256 + tid] = rsqrtf(((a0[0] + a0[1]) + (a0[2] + a0[3]) + (a1[0] + a1[1]) + (a1[2] + a1[3])) * (1.f / 512.f) + EPS);
        }
    }
    DEVI void mid(f32x4 (&)[2][2][4][2], int, int, int, PG8_LAS unsigned char*) const {}
    DEVI void operator()(AccRef acc, const pg8::Unit& u, int wr, int wc, int fr, int fq, int ui, PG8_LAS unsigned char* lds) const {
#pragma unroll
        for (int ai = 0; ai < 2; ++ai)
#pragma unroll
            for (int m = 0; m < 4; ++m) {
                const int rl = ai * 128 + wr * 64 + m * 16 + fr, row = u.pm * 256 + rl;
                const float rsv = ((const PG8_LAS float*)(lds + LDS_TAB))[(ui & 1) * 256 + rl];
                const size_t o = (size_t)(row - 16384) * 1024; const float* xr = p.x_sample + o; float* yo = p.out + O_YS + o;
#pragma unroll
                for (int bj = 0; bj < 2; ++bj)
#pragma unroll
                    for (int n = 0; n < 2; ++n) { const int f = u.pn * 256 + 128 * bj + 32 * wc + 8 * fq + 4 * n;
                        const f32x4 base = FIRST ? *(const f32x4*)(xr + f) : *(const f32x4*)(yo + f); *(f32x4*)(yo + f) = base + acc[ai][bj][m][n] * rsv; }
                asm volatile("" ::: "memory");
            }
    }
};
struct SchedOne { int pm, pn; DEVI bool next(int i, pg8::Unit& u) const { if (i != 0) return false; u.pm = pm; u.pn = pn; return true; } };
DEVI void glu_unit(const P& p, PG8_LAS unsigned char* lds, int pm, int pn) {
    pg8::Gemm g{gb_base(p.ws, pm >= 64), (const bf16_t*)(p.ws + W_WGLUT), 512, 512, 512}; SchedOne S{pm, pn}; EpiGlu E{p};
    pg8::gemm_phase<EpiGlu, SchedOne>(lds, g, S, E);
}
DEVI void out_unit(const P& p, PG8_LAS unsigned char* lds, int pm, int pn) {
    pg8::Gemm g{(const bf16_t*)(p.ws + W_CAT), (const bf16_t*)(p.ws + W_WOUTT), 1024, 1024, 1024}; SchedOne S{pm, pn}; EpiOut E{p};
    pg8::gemm_phase<EpiOut, SchedOne>(lds, g, S, E);
}
template <bool FIRST>
DEVI void out_half_unit(const P& p, PG8_LAS unsigned char* lds, int pm, int pn) {
    pg8::Gemm g{(const bf16_t*)(p.ws + W_CAT) + (FIRST ? 0 : 512), (const bf16_t*)(p.ws + W_WOUTT) + (FIRST ? 0 : 512), 1024, 1024, 512}; SchedOne S{pm, pn}; EpiOutHalf<FIRST> E{p};
    pg8::gemm_phase<EpiOutHalf<FIRST>, SchedOne>(lds, g, S, E);
}
DEVI void phase2b_gemm(const P& p, PG8_LAS unsigned char* lds) {
    const int c = blockIdx.x;
    if (c >= 248) glu_unit(p, lds, 64 + ((c - 248) >> 1), (c - 248) & 1);
    else out_half_unit<true>(p, lds, 64 + ((c - 232) >> 2), (c - 232) & 3);
}
DEVI void phase3a(const P& p, PG8_LAS unsigned char* lds) {
    const int c = blockIdx.x;
    if (c < 128) { const int x = c & 7, s = c >> 3; glu_unit(p, lds, x * 8 + (s >> 1), s & 1); }
    else if (c < 144) out_half_unit<false>(p, lds, 64 + ((c - 128) >> 2), (c - 128) & 3);
}
DEVI void phase3b(const P& p, PG8_LAS unsigned char* lds) { const int c = blockIdx.x, x = c & 7, s = c >> 3; out_unit(p, lds, x * 8 + (s >> 2), s & 3); }

__global__ void __launch_bounds__(512, 2) hymba_fwd(P p) {
    extern __shared__ __attribute__((aligned(16))) unsigned char lds_dyn[];
    PG8_LAS unsigned char* lds = (PG8_LAS unsigned char*)lds_dyn;
    if (threadIdx.x < 16) ((PG8_LAS unsigned*)(lds + LDS_XB))[threadIdx.x] = 0u;
    __syncthreads();
    XcdBarrier xb = xcd_barrier_post((unsigned*)(p.ws + W_BAR), (volatile LAS unsigned*)(lds + LDS_XB));
#ifndef REP0
#define REP0 1
#define REP1 1
#define REP2A 1
#define REP2B 1
#define REP3A 1
#define REP3B 1
#endif
    for (int r = 0; r < REP0; ++r) { phase0(p); xcd_barrier(xb); }
    for (int r = 0; r < REP1; ++r) { phase1(p, lds); xcd_barrier(xb); }
    for (int r = 0; r < REP2A; ++r) { phase2a(p, (char*)lds_dyn); xcd_barrier(xb); }
    if (blockIdx.x < 232) phase2b(p, (char*)lds_dyn); else phase2b_gemm(p, lds);
    xcd_barrier(xb);
    for (int r = 0; r < REP3A; ++r) { phase3a(p, lds); xcd_barrier(xb); }
    for (int r = 0; r < REP3B; ++r) { phase3b(p, lds); if (r + 1 < REP3B) xcd_barrier(xb); }
}

extern "C" void kernel_launch(void* const* d_in, const int* in_sizes, int n_in, void* d_out, int out_size, void* d_ws, size_t ws_size, hipStream_t stream) {
    P p{};
    const float** pp = (const float**)&p;
    for (int i = 0; i < 25; ++i) pp[i] = (const float*)d_in[i];
    p.out = (float*)d_out; p.ws = (char*)d_ws;
    static int grid_blocks = 0;
    if (!grid_blocks) {
        int dev = 0, cus = 0, per_cu = 0;
        (void)hipGetDevice(&dev);
        (void)hipDeviceGetAttribute(&cus, hipDeviceAttributeMultiprocessorCount, dev);
        (void)hipFuncSetAttribute((const void*)hymba_fwd, hipFuncAttributeMaxDynamicSharedMemorySize, LDS_BYTES);
        (void)hipOccupancyMaxActiveBlocksPerMultiprocessor(&per_cu, hymba_fwd, 512, LDS_BYTES);
        if (per_cu < 1) fprintf(stderr, "occupancy query reports %d blocks per CU\n", per_cu);
        grid_blocks = cus;
    }
    (void)hipMemsetAsync((char*)d_ws + W_BAR, 0, 16384, stream);
    void* args[] = {&p};
    hipError_t e = hipLaunchCooperativeKernel((void*)hymba_fwd, dim3(grid_blocks), dim3(512), args, LDS_BYTES, stream);
    if (e != hipSuccess) fprintf(stderr, "cooperative launch failed: %s (grid %d)\n", hipGetErrorString(e), grid_blocks);
}
```

```cpp
#include <hip/hip_runtime.h>
#include <hip/hip_cooperative_groups.h>
#include <cstdio>
#include <cstdint>
namespace cg = cooperative_groups;

#ifndef SINGLE_LAUNCH
#define SINGLE_LAUNCH 1
#endif

#define DEVI __device__ __forceinline__
typedef unsigned short bf16_t;
typedef short bf16x8 __attribute__((ext_vector_type(8)));
typedef float f32x4 __attribute__((ext_vector_type(4)));
typedef float f32x16 __attribute__((ext_vector_type(16)));
typedef unsigned u32x2 __attribute__((ext_vector_type(2)));
typedef float f32x2 __attribute__((ext_vector_type(2)));
typedef unsigned u32x4 __attribute__((ext_vector_type(4)));

constexpr int LP = 8208;
constexpr int NPR = 2 * LP;
constexpr int NROWS = NPR + 1024;
constexpr int NROWS_PAD = 17664;
constexpr int NBLK = 514 + 640;
constexpr float EPS = 1e-6f;
constexpr float LOG2E = 1.4426950408889634f;
constexpr float QSCALE = 0.125f * LOG2E;

constexpr size_t O_YP = 0, O_YS = 16777216, O_KWP = 17825792, O_VWP = 17858560, O_SRP = 17891328, O_SIP = 17895424,
                 O_KNS = 17899520, O_VNS = 18030592, O_SRS = 18161664, O_SIS = 18423808;

constexpr size_t al256(size_t x) { return (x + 255) & ~(size_t)255; }
constexpr size_t W_BAR = 0;
constexpr size_t W_XB = 16384;
constexpr size_t W_RS = al256(W_XB + (size_t)NROWS_PAD * 1024 * 2);
constexpr size_t W_WINT = al256(W_RS + (size_t)NROWS_PAD * 4);
constexpr size_t W_WGLUT = al256(W_WINT + (size_t)2304 * 1024 * 2);
constexpr size_t W_WOUTT = al256(W_WGLUT + (size_t)512 * 512 * 2);
constexpr size_t W_ROPE = al256(W_WOUTT + (size_t)1024 * 1024 * 2);
constexpr size_t W_LAM = al256(W_ROPE + (size_t)LP * 32 * 8);
constexpr size_t W_LAM64 = al256(W_LAM + 32 * 64 * 8);
constexpr size_t W_BBARF = al256(W_LAM64 + 32 * 64 * 8);
constexpr size_t W_CMF = al256(W_BBARF + 32 * 4 * 64 * 8 * 2);
constexpr size_t W_QB = al256(W_CMF + 32 * 4 * 64 * 8 * 2);
constexpr size_t W_KF = al256(W_QB + (size_t)NROWS_PAD * 512 * 2);
constexpr size_t W_VF = al256(W_KF + (size_t)2 * NBLK * 4 * 64 * 8 * 2);
constexpr size_t W_GA = al256(W_VF + (size_t)2 * NBLK * 4 * 64 * 8 * 2);
constexpr size_t W_GS = al256(W_GA + (size_t)NROWS_PAD * 512 * 2);
constexpr size_t W_UG = al256(W_GS + (size_t)NROWS_PAD * 512 * 2);
constexpr size_t W_CAT = W_XB;
constexpr size_t W_SSQA = al256(W_UG + (size_t)NROWS_PAD * 512 * 2);
constexpr size_t W_GB = W_QB;
constexpr size_t W_GBS = al256(W_SSQA + (size_t)NROWS_PAD * 8 * 4);
constexpr size_t W_SSQS = al256(W_GBS + (size_t)1024 * 512 * 2);
DEVI bf16_t* gb_base(char* ws, bool sample_rows) { return sample_rows ? (bf16_t*)(ws + W_GBS) - (size_t)16384 * 512 : (bf16_t*)(ws + W_GB); }
constexpr size_t W_ENDS = al256(W_SSQS + (size_t)NROWS_PAD * 8 * 4);
constexpr size_t W_CARRY = al256(W_ENDS + (size_t)2 * 32 * 128 * 64 * 8);
constexpr size_t W_TOTAL = al256(W_CARRY + (size_t)2 * 32 * 129 * 64 * 8);

constexpr int LDS_XB = 131072 + 4096;
constexpr int LDS_BYTES = LDS_XB + 64;

struct P {
    const float *x_prompt, *x_sample, *cache_k, *cache_v, *st_re, *st_im, *meta, *norm_w, *w_in, *q_norm_w, *k_norm_w, *sinks,
        *aon_w, *A_re, *A_im, *log_dt, *B_re, *B_im, *C_re, *C_im, *Dk, *w_glu, *b_glu, *son_w, *w_out;
    float* out;
    char* ws;
};

DEVI int tidx() { int t = threadIdx.x; asm volatile("" : "+v"(t)); return t; }
constexpr int NROWS3 = 17408;
DEVI int row3_of(int row) {
    if (row >= NPR) return 16384 + (row - NPR);
    const int b = row >= LP ? 1 : 0, pos = row - b * LP;
    return pos >= 16 ? b * 8192 + pos - 16 : NROWS3 + b * 16 + pos;
}
typedef __bf16 bf16x2_t __attribute__((ext_vector_type(2)));
DEVI unsigned pk2(float lo, float hi) { const f32x2 v = {lo, hi}; const bf16x2_t b = __builtin_convertvector(v, bf16x2_t); return __builtin_bit_cast(unsigned, b); }
DEVI bf16_t f2bf(float f) { return (bf16_t)(pk2(f, 0.f) & 0xffffu); }
DEVI float bf2f(unsigned short b) { return __uint_as_float(((unsigned)b) << 16); }
DEVI float bflo(unsigned w) { return __uint_as_float(w << 16); }
DEVI float bfhi(unsigned w) { return __uint_as_float(w & 0xffff0000u); }
DEVI float silu_f(float x) { return x * __builtin_amdgcn_rcpf(1.f + __expf(-x)); }
DEVI float sigmoid_f(float x) { return __builtin_amdgcn_rcpf(1.f + __expf(-x)); }
DEVI float gelu_tanh(float x) {
    const float u = 1.5957691216057308f * (x + 0.044715f * x * x * x);
    return x * __builtin_amdgcn_rcpf(1.f + __expf(-u));
}
DEVI f32x4 mfma16(bf16x8 a, bf16x8 b, f32x4 c) { return __builtin_amdgcn_mfma_f32_16x16x32_bf16(a, b, c, 0, 0, 0); }
DEVI f32x16 mfma32(bf16x8 a, bf16x8 b, f32x16 c) { return __builtin_amdgcn_mfma_f32_32x32x16_bf16(a, b, c, 0, 0, 0); }
DEVI bf16x8 mk8(unsigned a, unsigned b, unsigned c, unsigned d) { u32x4 t = {a, b, c, d}; return __builtin_bit_cast(bf16x8, t); }


#define XB_TMO      128
#define XB_XCNT(j)  (256  + 64 * (j))
#define XB_XSUB(j)  (1280 + 64 * (j))
#define XB_XGEN(j)  (2304 + 64 * (j))
#define XB_TOP      3328
#define XB_TOPGEN   3392
#define XCD_BAR_WORDS 3456
#define XB_SPIN_CAP (1u << 18)
#define LAS __attribute__((address_space(3)))
DEVI unsigned xb_ld(unsigned* p) { return __hip_atomic_load(p, __ATOMIC_RELAXED, __HIP_MEMORY_SCOPE_AGENT); }
DEVI unsigned xb_add(unsigned* p, unsigned v) { return __hip_atomic_fetch_add(p, v, __ATOMIC_RELAXED, __HIP_MEMORY_SCOPE_AGENT); }
DEVI unsigned xb_xcc_id() { return (unsigned)__builtin_amdgcn_s_getreg((3 << 11) | 20) & 0xFu; }
#define XB_SPIN(cond, bar) do { unsigned _sp = 0; while (cond) { __builtin_amdgcn_s_sleep(1); \
    if ((++_sp & 255u) == 0u) { if (xb_ld(&(bar)[XB_TMO])) break; if (_sp > XB_SPIN_CAP) { atomicAdd(&(bar)[XB_TMO], 1u); break; } } } } while (0)
struct XcdBarrier { unsigned* bar; unsigned x; volatile LAS unsigned* st; };
DEVI XcdBarrier xcd_barrier_post(unsigned* bar, volatile LAS unsigned* st) {
    XcdBarrier b; b.bar = bar; b.x = xb_xcc_id(); b.st = st;
    if (tidx() == 0) (void)xb_add(&bar[XB_XCNT(b.x)], 1u);
    return b;
}
DEVI void xcd_barrier_complete(unsigned* bar, unsigned x, unsigned& nloc, unsigned& nx) {
    const unsigned G = gridDim.x * gridDim.y * gridDim.z;
    unsigned sum, cnt, mine, sp = 0u;
    for (;;) {
        sum = 0u; cnt = 0u; mine = 0u;
#pragma unroll
        for (unsigned j = 0; j < 16; ++j) { const unsigned c = xb_ld(&bar[XB_XCNT(j)]); sum += c; cnt += (c > 0u) ? 1u : 0u; mine = (j == x) ? c : mine; }
        if (sum == G) break;
        __builtin_amdgcn_s_sleep(1);
        if ((++sp & 255u) == 0u) { if (xb_ld(&bar[XB_TMO])) break; if (sp > XB_SPIN_CAP) { atomicAdd(&bar[XB_TMO], 1u); break; } }
    }
    nloc = mine > 0u ? mine : 1u; nx = cnt > 0u ? cnt : 1u;
}
DEVI void xcd_barrier(const XcdBarrier& b) {
    asm volatile("s_waitcnt vmcnt(0)" ::: "memory");
    __syncthreads();
    if (tidx() == 0) {
        unsigned* bar = b.bar;
        __builtin_amdgcn_s_waitcnt(0);
        unsigned nloc = b.st[0], nx = b.st[1];
        if (nloc == 0u) { xcd_barrier_complete(bar, b.x, nloc, nx); b.st[0] = nloc; b.st[1] = nx; }
        const unsigned old = xb_add(&bar[XB_XSUB(b.x)], 1u);
        const unsigned gen = old / nloc;
        if (old + 1u == (gen + 1u) * nloc) {
            __builtin_amdgcn_fence(__ATOMIC_RELEASE, "agent");
            asm volatile("s_waitcnt vmcnt(0)" ::: "memory");
            const unsigned og = xb_add(&bar[XB_TOP], 1u);
            const unsigned tg = og / nx;
            if (og + 1u == (tg + 1u) * nx) xb_add(&bar[XB_TOPGEN], 1u);
            else XB_SPIN(xb_ld(&bar[XB_TOPGEN]) == tg, bar);
            __builtin_amdgcn_fence(__ATOMIC_ACQUIRE, "agent");
            xb_add(&bar[XB_XGEN(b.x)], 1u);
            asm volatile("s_waitcnt vmcnt(0)" ::: "memory");
        } else {
            XB_SPIN(xb_ld(&bar[XB_XGEN(b.x)]) == gen, bar);
            __builtin_amdgcn_fence(__ATOMIC_ACQUIRE, "agent");
            asm volatile("s_waitcnt vmcnt(0)" ::: "memory");
        }
    }
    __syncthreads();
}

DEVI const float* row_src(const P& p, int r) {
    if (r < NPR) { const int b = r >= LP ? 1 : 0, pos = r - b * LP; return pos < 16 ? p.meta + (size_t)pos * 1024 : p.x_prompt + ((size_t)b * 8192 + pos - 16) * 1024; }
    if (r < NROWS) return p.x_sample + (size_t)(r - NPR) * 1024;
    return nullptr;
}

DEVI void p0_ssm_f(const P& p, int i, float& fre, float& fim, float2& lamv, float2& lam64v) {
    const int g = i >> 6;
    const double dt = exp((double)p.log_dt[g]), are = p.A_re[i], aim = p.A_im[i];
    const double mag = exp(dt * are);
    double th = dt * aim * 0.15915494309189535; th -= rint(th); th *= 6.283185307179586;
    const float thf = (float)th; const float sh = sinf(0.5f * thf);
    const double lr = mag * (double)cosf(thf), li = mag * (double)sinf(thf);
    const double lrm1 = expm1(dt * are) - mag * 2.0 * (double)sh * (double)sh;
    lamv = make_float2((float)lr, (float)li);
    const double mag64 = exp(64.0 * dt * are);
    double th64 = 64.0 * dt * aim * 0.15915494309189535; th64 -= rint(th64); th64 *= 6.283185307179586;
    lam64v = make_float2((float)(mag64 * (double)cosf((float)th64)), (float)(mag64 * (double)sinf((float)th64)));
    const double den = are * are + aim * aim;
    fre = (float)((lrm1 * are + li * aim) / den); fim = (float)((li * are - lrm1 * aim) / den);
}

DEVI void phase0(const P& p) {
    const int gtid = blockIdx.x * 512 + tidx(), gsz = gridDim.x * 512;
    const int gw = gtid >> 6, nw = gsz >> 6, lane = tidx() & 63;
    bf16_t* xb = (bf16_t*)(p.ws + W_XB); float* rs = (float*)(p.ws + W_RS);
    for (int r = gw * 2; r < NROWS_PAD; r += nw * 2) {
        const float* src0 = row_src(p, r); const float* src1 = row_src(p, r + 1);
        f32x4 v[2][4]; float ss0 = 0.f, ss1 = 0.f;
#pragma unroll
        for (int i = 0; i < 4; ++i) {
            v[0][i] = src0 ? *(const f32x4*)(src0 + (i * 64 + lane) * 4) : (f32x4){0.f, 0.f, 0.f, 0.f};
            v[1][i] = src1 ? *(const f32x4*)(src1 + (i * 64 + lane) * 4) : (f32x4){0.f, 0.f, 0.f, 0.f};
        }
#pragma unroll
        for (int i = 0; i < 4; ++i) {
            ss0 += v[0][i][0] * v[0][i][0] + v[0][i][1] * v[0][i][1] + v[0][i][2] * v[0][i][2] + v[0][i][3] * v[0][i][3];
            ss1 += v[1][i][0] * v[1][i][0] + v[1][i][1] * v[1][i][1] + v[1][i][2] * v[1][i][2] + v[1][i][3] * v[1][i][3];
        }
#pragma unroll
        for (int o = 32; o >= 1; o >>= 1) { ss0 += __shfl_xor(ss0, o); ss1 += __shfl_xor(ss1, o); }
        if (lane == 0) { rs[r] = rsqrtf(ss0 * (1.f / 1024.f) + EPS); rs[r + 1] = rsqrtf(ss1 * (1.f / 1024.f) + EPS); }
#pragma unroll
        for (int i = 0; i < 4; ++i) {
            u32x2 w0 = {pk2(v[0][i][0], v[0][i][1]), pk2(v[0][i][2], v[0][i][3])}; *(u32x2*)(xb + (size_t)r * 1024 + (i * 64 + lane) * 4) = w0;
            u32x2 w1 = {pk2(v[1][i][0], v[1][i][1]), pk2(v[1][i][2], v[1][i][3])}; *(u32x2*)(xb + (size_t)(r + 1) * 1024 + (i * 64 + lane) * 4) = w1;
        }
    }
    bf16_t* winT = (bf16_t*)(p.ws + W_WINT);
    for (int i = gtid; i < 2304 * 128; i += gsz) {
        const int n = i % 2304, k8 = i / 2304; float t[8];
        const int f = (n & ~255) + ((n >> 5) & 3) * 64 + ((n >> 7) & 1) * 32 + (n & 31);
#pragma unroll
        for (int j = 0; j < 8; ++j) t[j] = p.w_in[(size_t)(k8 * 8 + j) * 2304 + f] * p.norm_w[k8 * 8 + j];
        u32x4 w = {pk2(t[0], t[1]), pk2(t[2], t[3]), pk2(t[4], t[5]), pk2(t[6], t[7])};
        *(u32x4*)(winT + (size_t)n * 1024 + k8 * 8) = w;
    }
    {
        bf16_t* kF = (bf16_t*)(p.ws + W_KF); bf16_t* vF = (bf16_t*)(p.ws + W_VF);
        for (int i = gtid; i < 2 * 130 * 256; i += gsz) {
            const int piece = i & 255, s = (i >> 8) % 130, kvh = (i >> 8) / 130;
            const int blk = s < 2 ? s * 257 + 256 : 514 + (s - 2) * 5 + 4;
            const u32x4 z = {0u, 0u, 0u, 0u};
            *(u32x4*)(kF + (size_t)(kvh * NBLK + blk) * 2048 + piece * 8) = z;
            *(u32x4*)(vF + (size_t)(kvh * NBLK + blk) * 2048 + piece * 8) = z;
        }
    }
    float2* rope = (float2*)(p.ws + W_ROPE);
    for (int i = gtid; i < LP * 32; i += gsz) {
        const int pos = i >> 5, d = i & 31;
        const double inv = exp2(-(double)d * (13.287712379549449 / 32.0));
        double t = (double)pos * inv * 0.15915494309189535; t -= rint(t);
        const float r = (float)(t * 6.283185307179586);
        rope[i] = make_float2(cosf(r), sinf(r));
    }
}

DEVI void deferred_prep(const P& p, int gtid, int gsz) {
    bf16_t* wgT = (bf16_t*)(p.ws + W_WGLUT);
    for (int i = gtid; i < 512 * 64; i += gsz) {
        const int n = i % 512, k8 = i / 512; float t[8];
#pragma unroll
        for (int j = 0; j < 8; ++j) t[j] = p.w_glu[(size_t)(k8 * 8 + j) * 512 + n];
        u32x4 w = {pk2(t[0], t[1]), pk2(t[2], t[3]), pk2(t[4], t[5]), pk2(t[6], t[7])};
        *(u32x4*)(wgT + (size_t)n * 512 + k8 * 8) = w;
    }
    bf16_t* woT = (bf16_t*)(p.ws + W_WOUTT);
    for (int i = gtid; i < 1024 * 128; i += gsz) {
        const int n = i % 1024, k8 = i / 1024; float t[8];
#pragma unroll
        for (int j = 0; j < 8; ++j) { const int k = k8 * 8 + j; t[j] = p.w_out[(size_t)k * 1024 + n] * (k < 512 ? p.aon_w[k] : p.son_w[k - 512]); }
        u32x4 w = {pk2(t[0], t[1]), pk2(t[2], t[3]), pk2(t[4], t[5]), pk2(t[6], t[7])};
        *(u32x4*)(woT + (size_t)n * 1024 + k8 * 8) = w;
    }
    {
        bf16_t* kF = (bf16_t*)(p.ws + W_KF); bf16_t* vF = (bf16_t*)(p.ws + W_VF);
        for (int i = gtid; i < 2 * 128 * 4 * 4 * 64; i += gsz) {
            const int ln = i & 63, ks = (i >> 6) & 3, kb = (i >> 8) & 3, db = (i >> 10) & 127, kvh = i >> 17;
            const float* kp = p.cache_k + ((size_t)(db * 128 + kb * 32 + (ln & 31)) * 2 + kvh) * 64 + ks * 16 + (ln >> 5) * 8;
            const f32x4 a = *(const f32x4*)kp, c = *(const f32x4*)(kp + 4);
            u32x4 w = {pk2(a[0], a[1]), pk2(a[2], a[3]), pk2(c[0], c[1]), pk2(c[2], c[3])};
            *(u32x4*)(kF + ((size_t)((kvh * NBLK + 514 + db * 5 + kb) * 4 + ks) * 64 + ln) * 8) = w;
            const int db2 = ks >> 1, s2 = ks & 1, h = ln >> 5; float t[8];
#pragma unroll
            for (int j = 0; j < 8; ++j) { const int key = 16 * s2 + 8 * (j >> 2) + 4 * h + (j & 3);
                t[j] = p.cache_v[((size_t)(db * 128 + kb * 32 + key) * 2 + kvh) * 64 + db2 * 32 + (ln & 31)]; }
            u32x4 wv = {pk2(t[0], t[1]), pk2(t[2], t[3]), pk2(t[4], t[5]), pk2(t[6], t[7])};
            *(u32x4*)(vF + ((size_t)(((kvh * NBLK + 514 + db * 5 + kb) * 2 + db2) * 2 + s2) * 64 + ln) * 8) = wv;
        }
    }
    float2* lam = (float2*)(p.ws + W_LAM); float2* lam64 = (float2*)(p.ws + W_LAM64);
    bf16_t* bbarF = (bf16_t*)(p.ws + W_BBARF); bf16_t* cmF = (bf16_t*)(p.ws + W_CMF);
    for (int e = gsz - 1 - gtid; e < 32 * 64 * 16; e += gsz) {
        const int i = e >> 4, h = e & 15, g = i >> 6, n = i & 63;
        float fre, fim; float2 lv, l64v; p0_ssm_f(p, i, fre, fim, lv, l64v);
        if (h == 0) { lam[i] = lv; lam64[i] = l64v; }
        const float Br = p.B_re[(size_t)i * 16 + h], Bi = p.B_im[(size_t)i * 16 + h];
        const float bre = fre * Br - fim * Bi, bim = fre * Bi + fim * Br;
        const int cf0 = (n >= 32 ? 2 : 0), ln = (h >> 3) * 32 + (n & 31), j = h & 7;
        bbarF[((size_t)(g * 4 + cf0) * 64 + ln) * 8 + j] = f2bf(bre);
        bbarF[((size_t)(g * 4 + cf0 + 1) * 64 + ln) * 8 + j] = f2bf(bim);
        const int ho = h;
        const float cre = p.C_re[(size_t)(g * 16 + ho) * 64 + n], cim = p.C_im[(size_t)(g * 16 + ho) * 64 + n];
#pragma unroll
        for (int part = 0; part < 2; ++part) {
            const int kk = 2 * n + part, ks = kk >> 5, q = (kk & 31) >> 3, jj = kk & 7, ln2 = q * 16 + ho;
            cmF[((size_t)(g * 4 + ks) * 64 + ln2) * 8 + jj] = f2bf(part ? -cim : cre);
        }
    }
}

template <bool SAMPLE>
DEVI int attn_blk(int kb, int ia, int b, int q0) {
    if (SAMPLE) return 514 + ia * 5 + kb;
    int kpos0 = q0 - 128 + 32 * kb; kpos0 = kpos0 < 0 ? 0 : kpos0;
    return b * 257 + (kpos0 >> 5);
}
DEVI void attn_load_k(const P& p, int blk, int kvh, int lane, bf16x8 (&kfr)[4]) {
    const bf16_t* kF = (const bf16_t*)(p.ws + W_KF);
#pragma unroll
    for (int ks = 0; ks < 4; ++ks) kfr[ks] = *(const bf16x8*)(kF + ((size_t)((kvh * NBLK + blk) * 4 + ks) * 64 + lane) * 8);
}
DEVI void attn_load_v(const P& p, int blk, int kvh, int lane, bf16x8 (&vfr)[2][2]) {
    const bf16_t* vF = (const bf16_t*)(p.ws + W_VF);
#pragma unroll
    for (int db2 = 0; db2 < 2; ++db2)
#pragma unroll
        for (int s2 = 0; s2 < 2; ++s2) vfr[db2][s2] = *(const bf16x8*)(vF + ((size_t)(((kvh * NBLK + blk) * 2 + db2) * 2 + s2) * 64 + lane) * 8);
}

template <bool SAMPLE>
DEVI void attn_unit(const P& p, int ia, int ib, int ic) {
    const int lane = tidx() & 63, c5 = lane & 31, h = lane >> 5;
    const bf16_t* qb = (const bf16_t*)(p.ws + W_QB);
    int rowq, head, kvh, b = 0, q0 = 0; bool qok;
    if (SAMPLE) { const int db = ia; kvh = ib; head = kvh * 4 + (c5 & 3); rowq = NPR + db * 8 + (c5 >> 2); qok = true; }
    else { b = ia; head = ib; kvh = head >> 2; q0 = ic * 32; rowq = b * LP + q0 + c5; qok = (q0 + c5) < LP; }
    bf16x8 kfr[5][4], vfr[3][2][2];
#pragma unroll
    for (int kb = 0; kb < 5; ++kb) attn_load_k(p, attn_blk<SAMPLE>(kb, ia, b, q0), kvh, lane, kfr[kb]);
    bf16x8 qf[4];
#pragma unroll
    for (int ks = 0; ks < 4; ++ks) qf[ks] = *(const bf16x8*)(qb + (size_t)rowq * 512 + head * 64 + ks * 16 + h * 8);
#pragma unroll
    for (int kb = 0; kb < 3; ++kb) attn_load_v(p, attn_blk<SAMPLE>(kb, ia, b, q0), kvh, lane, vfr[kb]);
    float m = p.sinks[head] * LOG2E, lsum = h == 0 ? 1.f : 0.f;
    f32x16 O[2];
#pragma unroll
    for (int i = 0; i < 16; ++i) { O[0][i] = 0.f; O[1][i] = 0.f; }
    const int tq = SAMPLE ? (c5 >> 2) : c5;
    auto body = [&](int kb, const bf16x8 (&kf)[4], const bf16x8 (&vf)[2][2]) {
        const bool blk_ok = SAMPLE ? true : (q0 - 128 + 32 * kb) >= 0;
        f32x16 S;
#pragma unroll
        for (int i = 0; i < 16; ++i) S[i] = 0.f;
#pragma unroll
        for (int ks = 0; ks < 4; ++ks) S = mfma32(kf[ks], qf[ks], S);
        float mx = -3.0e38f;
#pragma unroll
        for (int i = 0; i < 16; ++i) {
            const int ki = (i & 3) + 8 * (i >> 2) + 4 * h;
            bool valid = blk_ok;
            if (kb == 0) valid = valid && (ki > tq); else if (kb == 4) valid = valid && (ki <= tq);
            S[i] = valid ? S[i] : -3.0e38f;
            mx = fmaxf(mx, S[i]);
        }
        mx = fmaxf(mx, __shfl_xor(mx, 32));
        const float mnew = fmaxf(m, mx), alpha = exp2f(m - mnew); m = mnew;
        float ps = 0.f; float pv[16];
#pragma unroll
        for (int i = 0; i < 16; ++i) { pv[i] = exp2f(S[i] - mnew); ps += pv[i]; }
        lsum = lsum * alpha + ps;
#pragma unroll
        for (int i = 0; i < 16; ++i) { O[0][i] *= alpha; O[1][i] *= alpha; }
        const bf16x8 pf0 = mk8(pk2(pv[0], pv[1]), pk2(pv[2], pv[3]), pk2(pv[4], pv[5]), pk2(pv[6], pv[7]));
        const bf16x8 pf1 = mk8(pk2(pv[8], pv[9]), pk2(pv[10], pv[11]), pk2(pv[12], pv[13]), pk2(pv[14], pv[15]));
#pragma unroll
        for (int db2 = 0; db2 < 2; ++db2) { O[db2] = mfma32(vf[db2][0], pf0, O[db2]); O[db2] = mfma32(vf[db2][1], pf1, O[db2]); }
    };
    body(0, kfr[0], vfr[0]);
    attn_load_v(p, attn_blk<SAMPLE>(3, ia, b, q0), kvh, lane, vfr[0]);
    body(1, kfr[1], vfr[1]);
    attn_load_v(p, attn_blk<SAMPLE>(4, ia, b, q0), kvh, lane, vfr[1]);
    body(2, kfr[2], vfr[2]);
    body(3, kfr[3], vfr[0]);
    body(4, kfr[4], vfr[1]);
    lsum += __shfl_xor(lsum, 32);
    const float inv = 1.f / lsum;
    const bf16_t* ga = (const bf16_t*)(p.ws + W_GA) + (size_t)rowq * 512 + head * 64;
    const int rowq3 = row3_of(rowq);
    bf16_t* ao = (bf16_t*)(p.ws + W_CAT) + (size_t)rowq3 * 1024 + head * 64;
    float ssq = 0.f;
#pragma unroll
    for (int db2 = 0; db2 < 2; ++db2)
#pragma unroll
        for (int a = 0; a < 4; ++a) {
            const int d0 = db2 * 32 + 8 * a + 4 * h;
            const u32x2 gw = qok ? *(const u32x2*)(ga + d0) : (u32x2){0u, 0u};
            const float g0 = bflo(gw[0]), g1 = bfhi(gw[0]), g2 = bflo(gw[1]), g3 = bfhi(gw[1]);
            const float o0 = O[db2][4 * a] * inv * silu_f(g0), o1 = O[db2][4 * a + 1] * inv * silu_f(g1), o2 = O[db2][4 * a + 2] * inv * silu_f(g2), o3 = O[db2][4 * a + 3] * inv * silu_f(g3);
            ssq += o0 * o0 + o1 * o1 + o2 * o2 + o3 * o3;
            if (qok) { u32x2 w = {pk2(o0, o1), pk2(o2, o3)}; *(u32x2*)(ao + d0) = w; }
        }
    ssq += __shfl_xor(ssq, 32);
    if (qok && h == 0) ((float*)(p.ws + W_SSQA))[(size_t)rowq3 * 8 + head] = ssq;
}

template <bool PASS2, bool FULLV = false>
DEVI void ssm_item(const P& p, char* wlds, bool sample, int ia, int g, int c) {
    const int lane = tidx() & 63, c5 = lane & 31, hh = lane >> 5;
    const bf16_t* uG = (const bf16_t*)(p.ws + W_UG) + (size_t)g * NROWS_PAD * 16;
    const float2* lamT = (const float2*)(p.ws + W_LAM) + g * 64; const float2* lam64T = (const float2*)(p.ws + W_LAM64) + g * 64;
    const float2 l0 = lamT[c5], l1 = lamT[32 + c5];
    int rowbase, nvalid, nrb;
    if (sample) { rowbase = NPR + (2 * ia + hh) * 8; nvalid = 8; nrb = 1; }
    else { const int pos0 = c * 128 + 64 * hh; rowbase = ia * LP + pos0; nvalid = LP - pos0; nvalid = nvalid < 0 ? 0 : (nvalid > 64 ? 64 : nvalid); nrb = c == 64 ? 1 : 4; }
    bf16x8 bfr[4];
#pragma unroll
    for (int cf = 0; cf < 4; ++cf) bfr[cf] = *(const bf16x8*)((const bf16_t*)(p.ws + W_BBARF) + ((size_t)(g * 4 + cf) * 64 + lane) * 8);
    const int ar_ = lane & 31, ahalf_ = (ar_ >> 2) & 1, aidx_ = (ar_ & 3) + 4 * (ar_ >> 3);
    u32x4 uall[4]; u32x2 dall[4][2];
    { int rbase_a, nv_a;
      if (sample) { rbase_a = NPR + (2 * ia + ahalf_) * 8; nv_a = 8; } else { const int pos0 = c * 128 + 64 * ahalf_; rbase_a = ia * LP + pos0; nv_a = LP - pos0; nv_a = nv_a < 0 ? 0 : (nv_a > 64 ? 64 : nv_a); }
#pragma unroll
      for (int rb = 0; rb < 4; ++rb) { const int ti = rb * 16 + aidx_; uall[rb] = (u32x4){0u, 0u, 0u, 0u};
          if (rb < nrb && ti < nv_a) uall[rb] = *(const u32x4*)(uG + (size_t)(rbase_a + ti) * 16 + (lane >> 5) * 8); }
      if (PASS2) {
#pragma unroll
          for (int tb = 0; tb < 2; ++tb) { int rb_base, nv_t;
              if (sample) { rb_base = NPR + (2 * ia + tb) * 8; nv_t = 8; } else { const int pos0 = c * 128 + 64 * tb; rb_base = ia * LP + pos0; nv_t = LP - pos0; nv_t = nv_t < 0 ? 0 : (nv_t > 64 ? 64 : nv_t); }
#pragma unroll
              for (int rb = 0; rb < 4; ++rb) { const int ti = rb * 16 + (lane & 15); dall[rb][tb] = (u32x2){0u, 0u};
                  if (rb < nrb && ti < nv_t) dall[rb][tb] = *(const u32x2*)(uG + (size_t)(rb_base + ti) * 16 + (lane >> 4) * 4); } }
      }
    }
    float x0r = 0.f, x0i = 0.f, x1r = 0.f, x1i = 0.f;
    if (PASS2) {
        if (sample) { const size_t o = ((size_t)(2 * ia + hh) * 32 + g) * 64; x0r = p.st_re[o + c5]; x0i = p.st_im[o + c5]; x1r = p.st_re[o + 32 + c5]; x1i = p.st_im[o + 32 + c5]; }
        else {
            int sc = 2 * c + hh; sc = sc > 128 ? 128 : sc;
            const float2* cy = (const float2*)(p.ws + W_CARRY) + ((size_t)(ia * 32 + g) * 129 + sc) * 64;
            const float2 c0 = cy[c5], c1 = cy[32 + c5];
            x0r = c0.x; x0i = c0.y; x1r = c1.x; x1i = c1.y;
        }
    }
    bf16x8 cfr[4];
    float dsk[4];
    if (PASS2) {
#pragma unroll
        for (int ks = 0; ks < 4; ++ks) cfr[ks] = *(const bf16x8*)((const bf16_t*)(p.ws + W_CMF) + ((size_t)(g * 4 + ks) * 64 + lane) * 8);
        const f32x4 d4 = *(const f32x4*)(p.Dk + g * 16 + (lane >> 4) * 4);
        dsk[0] = d4[0]; dsk[1] = d4[1]; dsk[2] = d4[2]; dsk[3] = d4[3];
    }
#pragma unroll
    for (int rb = 0; rb < 4; ++rb) {
        if (rb >= nrb) break;
        {
          const bf16x8 af = __builtin_bit_cast(bf16x8, uall[rb]);
          f32x16 bu[4];
#pragma unroll
          for (int cf = 0; cf < 4; ++cf) {
#pragma unroll
              for (int i = 0; i < 16; ++i) bu[cf][i] = 0.f;
              bu[cf] = mfma32(af, bfr[cf], bu[cf]);
          }
          const int nv_here = nvalid - rb * 16;
          unsigned* xw = (unsigned*)wlds;
#pragma unroll
          for (int i = 0; i < 16; ++i) {
              const float a = l0.x * x0r - l0.y * x0i + bu[0][i], bq = l0.x * x0i + l0.y * x0r + bu[1][i];
              const float cc = l1.x * x1r - l1.y * x1i + bu[2][i], dq = l1.x * x1i + l1.y * x1r + bu[3][i];
              if (PASS2 && !FULLV) { const bool v = i < nv_here; x0r = v ? a : x0r; x0i = v ? bq : x0i; x1r = v ? cc : x1r; x1i = v ? dq : x1i; }
              else { x0r = a; x0i = bq; x1r = cc; x1i = dq; }
              if (PASS2) { xw[(hh * 16 + i) * 68 + c5] = pk2(x0r, x0i); xw[(hh * 16 + i) * 68 + 32 + c5] = pk2(x1r, x1i); }
          }
        }
        if (PASS2) {
#pragma unroll
            for (int tb = 0; tb < 2; ++tb) {
                f32x4 y = {0.f, 0.f, 0.f, 0.f};
#pragma unroll
                for (int ks = 0; ks < 4; ++ks) {
                    const bf16x8 xf = *(const bf16x8*)(wlds + (tb * 16 + (lane & 15)) * 272 + ks * 64 + (lane >> 4) * 16);
                    y = mfma16(cfr[ks], xf, y);
                }
                int rb_base, nv_t;
                if (sample) { rb_base = NPR + (2 * ia + tb) * 8; nv_t = 8; } else { const int pos0 = c * 128 + 64 * tb; rb_base = ia * LP + pos0; nv_t = LP - pos0; nv_t = nv_t < 0 ? 0 : (nv_t > 64 ? 64 : nv_t); }
                const int ti = rb * 16 + (lane & 15);
                if (ti < nv_t) {
                    const int row = rb_base + ti;
                    const u32x2 uw = dall[rb][tb];
                    const float y0 = y[0] + dsk[0] * bflo(uw[0]), y1 = y[1] + dsk[1] * bfhi(uw[0]), y2 = y[2] + dsk[2] * bflo(uw[1]), y3 = y[3] + dsk[3] * bfhi(uw[1]);
                    u32x2 w = {pk2(gelu_tanh(y0), gelu_tanh(y1)), pk2(gelu_tanh(y2), gelu_tanh(y3))};
                    *(u32x2*)(gb_base(p.ws, sample) + (size_t)row3_of(row) * 512 + g * 16 + (lane >> 4) * 4) = w;
                }
            }
        }
    }
    if (!PASS2) {
        float2* ends = (float2*)(p.ws + W_ENDS) + (size_t)(ia * 32 + g) * 128 * 64 + (size_t)(2 * c + hh) * 64;
        ends[c5] = make_float2(x0r, x0i); ends[32 + c5] = make_float2(x1r, x1i);
    } else {
        if (sample) { const size_t o = ((size_t)(2 * ia + hh) * 32 + g) * 64;
            p.out[O_SRS + o + c5] = x0r; p.out[O_SIS + o + c5] = x0i; p.out[O_SRS + o + 32 + c5] = x1r; p.out[O_SIS + o + 32 + c5] = x1i; }
        else if (c == 64 && hh == 0) { const size_t o = ((size_t)ia * 32 + g) * 64;
            p.out[O_SRP + o + c5] = x0r; p.out[O_SIP + o + c5] = x0i; p.out[O_SRP + o + 32 + c5] = x1r; p.out[O_SIP + o + 32 + c5] = x1i; }
    }
}

DEVI void phase2a(const P& p, char* lds) {
    const int tid = tidx(), wid = tid >> 6, lane = tid & 63;
    if (blockIdx.x < 64) {
        const int bg = blockIdx.x, g = bg & 31, b = bg >> 5;
#pragma unroll 1
        for (int k = 0; k < 8; ++k) ssm_item<false>(p, lds + wid * 8704, false, b, g, wid * 8 + k);
        asm volatile("s_waitcnt vmcnt(0)" ::: "memory");
        __syncthreads();
        const float2 L = ((const float2*)(p.ws + W_LAM64))[g * 64 + lane];
        const float2* ends = (const float2*)(p.ws + W_ENDS) + (size_t)bg * 128 * 64 + (size_t)(16 * wid) * 64 + lane;
        float2 e[16];
#pragma unroll
        for (int s = 0; s < 16; ++s) e[s] = ends[s * 64];
        float xr = 0.f, xi = 0.f;
#pragma unroll
        for (int s = 0; s < 16; ++s) { const float a = L.x * xr - L.y * xi + e[s].x, bq = L.x * xi + L.y * xr + e[s].y; xr = a; xi = bq; }
        float pr = L.x, pi = L.y;
#pragma unroll
        for (int k = 0; k < 4; ++k) { const float a = pr * pr - pi * pi, bq = 2.f * pr * pi; pr = a; pi = bq; }
        float2* seg = (float2*)lds;
        seg[wid * 64 + lane] = make_float2(xr, xi);
        __syncthreads();
        float cr = 0.f, ci = 0.f;
        for (int i = 0; i < wid; ++i) { const float2 q = seg[i * 64 + lane]; const float a = pr * cr - pi * ci + q.x, bq = pr * ci + pi * cr + q.y; cr = a; ci = bq; }
        float2* cy = (float2*)(p.ws + W_CARRY) + (size_t)bg * 129 * 64 + (size_t)(16 * wid) * 64 + lane;
        xr = cr; xi = ci;
#pragma unroll
        for (int s = 0; s < 16; ++s) { cy[s * 64] = make_float2(xr, xi); const float a = L.x * xr - L.y * xi + e[s].x, bq = L.x * xi + L.y * xr + e[s].y; xr = a; xi = bq; }
        if (wid == 7) cy[16 * 64] = make_float2(xr, xi);
        __syncthreads();
    } else {
        const int vb0 = (int)blockIdx.x - 64;
        const int w = ((vb0 & 7) * 24 + (vb0 >> 3)) * 8 + wid;
        for (int u = w; u < 4096; u += 1536) { const int head = u & 7, r = u >> 3, qblk = r & 255, b = r >> 8; attn_unit<false>(p, b, head, qblk); }
        { const int e = w - 1024; if (e >= 0 && e < 16) attn_unit<false>(p, e >> 3, e & 7, 256); }
        { const int s = w - 1024 - 16; if (s >= 0 && s < 256) attn_unit<true>(p, s >> 1, s & 1, 0); }
        if (w < 1296) ssm_item<true>(p, lds + wid * 8704, true, w >> 5, w & 31, 0);
        else for (int u = w; u < 2048; u += 240) ssm_item<true>(p, lds + wid * 8704, true, u >> 5, u & 31, 0);
    }
}
DEVI void phase2b(const P& p, char* lds) {
    const int wid = tidx() >> 6;
    for (int it = blockIdx.x * 8 + wid; it < 4096; it += 232 * 8) { const int c = it & 63, g = (it >> 6) & 31, b = it >> 11; ssm_item<true, true>(p, lds + wid * 8704, false, b, g, c); }
    for (int it = (231 - (int)blockIdx.x) * 8 + wid; it < 64; it += 232 * 8) ssm_item<true, false>(p, lds + wid * 8704, false, it >> 5, it & 31, 64);
}

namespace pg8 {
#define PG8_LAS __attribute__((address_space(3)))
constexpr int BM = 256, BK = 64, HALF = 128, HTB = HALF * BK * 2  , STAGE_BYTES = 8 * HTB, NXCD = 8, WGM = 8;
__host__ __device__ __forceinline__ int lds_byte(int r, int c) { const int st = (r >> 4) * 2 + (c >> 5), rr = r & 15, cc = c & 31, ob = rr * 64 + cc * 2; return st * 1024 + (ob ^ (((ob >> 9) & 1) << 5)); }
__host__ __device__ __forceinline__ void stage_rc(int b, int& R, int& C) { const int st = b / 1024, sb = b % 1024, swz = sb ^ (((sb >> 9) & 1) << 5); R = (st >> 1) * 16 + swz / 64; C = (st & 1) * 32 + (swz % 64) / 2; }
__host__ __device__ __forceinline__ int perm32(int rho) { const int n = rho >> 4, i = rho & 15; return 8 * (i >> 2) + 4 * n + (i & 3); }
struct Unit { int pm, pn; };
struct Gemm { const bf16_t* A; const bf16_t* Bt; int lda, ldb, K; };
struct StaticOrder {
    int nM, nN, nwg, G, c;
    __host__ __device__ void init(int M, int N, int G_, int c_) { nM = M / BM; nN = N / BM; nwg = nM * nN; G = G_; c = c_; }
    __host__ __device__ bool next(int i, Unit& u) const {
        const long L = (long)i * G + c; if (L >= nwg) return false;
        int wgid = (int)L; { const int q = nwg / NXCD, r = nwg % NXCD, xcd = wgid % NXCD, off = wgid / NXCD; wgid = (xcd < r ? xcd * (q + 1) : r * (q + 1) + (xcd - r) * q) + off; }
        const int nig = WGM * nN, gid = wgid / nig, fm = gid * WGM, gsz = (nM - fm) < WGM ? (nM - fm) : WGM;
        u.pm = fm + ((wgid % nig) % gsz); u.pn = (wgid % nig) / gsz; return true;
    }
};
template <class Epi, class Sched>
__device__ __forceinline__ void gemm_phase(PG8_LAS unsigned char* lds, const Gemm g, const Sched& S, const Epi& E) {
    const int tid = tidx(), wid = __builtin_amdgcn_readfirstlane(tid >> 6), lane = tid & 63, wr = wid >> 2, wc = wid & 3, fr = lane & 15, fq = lane >> 4;
    const int K = g.K, nt = K / BK;
    unsigned voffA[2], voffB[2];
#pragma unroll
    for (int i = 0; i < 2; ++i) { int R, C; stage_rc(tid * 16 + i * 8192, R, C); const int Rb = (R & ~31) + perm32(R & 31); voffA[i] = (unsigned)(R * g.lda + C) * 2u; voffB[i] = (unsigned)(Rb * g.ldb + C) * 2u; }
    const size_t kstep = (size_t)(BK * 2);
    const size_t hstepA = (size_t)HALF * g.lda * 2, hstepB = (size_t)HALF * g.ldb * 2;
    const size_t tstepA = 2 * hstepA, tstepB = 2 * hstepB;
    const unsigned ldsw = (unsigned)wid * 1024u;
    const int aoff = lds_byte(wr * 64 + fr, fq * 8), boff = lds_byte(wc * 32 + fr, fq * 8);
#define PG8_SA(b, h) (((b) * 2 + (h)) * HTB)
#define PG8_SB(b, h) ((4 + (b) * 2 + (h)) * HTB)
#define PG8_STAGE(bufoff, gbase, voff) do { _Pragma("unroll") for (int _i = 0; _i < 2; ++_i) \
        __builtin_amdgcn_global_load_lds((const unsigned*)((const char*)(gbase) + (voff)[_i]), (PG8_LAS unsigned*)(lds + (bufoff) + ldsw + _i * 8192), 16, 0, 0); } while (0)
#define PG8_LDA(dst, b, h) do { _Pragma("unroll") for (int m = 0; m < 4; ++m) _Pragma("unroll") for (int k = 0; k < 2; ++k) dst[m][k] = *(const PG8_LAS bf16x8*)(lds + PG8_SA(b, h) + aoff + m * 2048 + k * 1024); } while (0)
#define PG8_LDB(dst, b, h) do { _Pragma("unroll") for (int n = 0; n < 2; ++n) _Pragma("unroll") for (int k = 0; k < 2; ++k) dst[n][k] = *(const PG8_LAS bf16x8*)(lds + PG8_SB(b, h) + boff + n * 2048 + k * 1024); } while (0)
#define PG8_MMA(ai, bj, At, Bt) do { __builtin_amdgcn_s_setprio(1); _Pragma("unroll") for (int m = 0; m < 4; ++m) _Pragma("unroll") for (int n = 0; n < 2; ++n) _Pragma("unroll") for (int k = 0; k < 2; ++k) \
        acc[ai][bj][m][n] = __builtin_amdgcn_mfma_f32_16x16x32_bf16(Bt[n][k], At[m][k], acc[ai][bj][m][n], 0, 0, 0); __builtin_amdgcn_s_setprio(0); } while (0)
#define PG8_WAIT_V(n) asm volatile("s_waitcnt vmcnt(" #n ")" ::: "memory")
#define PG8_WAIT_L(n) asm volatile("s_waitcnt lgkmcnt(" #n ")" ::: "memory")
#define PG8_BAR __builtin_amdgcn_s_barrier()
#define PG8_SCHED __builtin_amdgcn_sched_barrier(0)
    Unit cur, nxt; int ui = 0;
    if (!S.next(0, cur)) return;
    f32x4 acc[2][2][4][2];
#pragma unroll
    for (int a = 0; a < 2; ++a)
#pragma unroll
        for (int b = 0; b < 2; ++b)
#pragma unroll
            for (int m = 0; m < 4; ++m)
#pragma unroll
                for (int n = 0; n < 2; ++n) acc[a][b][m][n] = (f32x4){0.f, 0.f, 0.f, 0.f};
    bf16x8 At[4][2], B0[2][2], B1[2][2];
    const char* cA = (const char*)g.A + (size_t)cur.pm * tstepA; const char* cB = (const char*)g.Bt + (size_t)cur.pn * tstepB;
    E.begin(cur, 0, tid, lds);
    asm volatile("s_waitcnt vmcnt(0) lgkmcnt(0)" ::: "memory");
    PG8_BAR;
    PG8_STAGE(PG8_SB(0, 0), cB, voffB); PG8_STAGE(PG8_SB(0, 1), cB + hstepB, voffB); PG8_STAGE(PG8_SA(0, 0), cA, voffA); PG8_STAGE(PG8_SA(0, 1), cA + hstepA, voffA);
    if (wr == 1) PG8_BAR;
    PG8_WAIT_V(2); PG8_BAR;
    PG8_STAGE(PG8_SB(1, 0), cB + kstep, voffB); PG8_STAGE(PG8_SA(1, 0), cA + kstep, voffA); PG8_STAGE(PG8_SB(1, 1), cB + hstepB + kstep, voffB);
    PG8_WAIT_V(6); PG8_BAR;
    for (;;) {
        const bool has_next = S.next(ui + 1, nxt);
        const char* nA = has_next ? (const char*)g.A + (size_t)nxt.pm * tstepA : cA; const char* nB = has_next ? (const char*)g.Bt + (size_t)nxt.pn * tstepB : cB;
        for (int t = 0; t < nt; t += 2) {
            const bool last = (t == nt - 2);
            const char* a1 = cA + (size_t)(t + 1) * kstep;
            const char* a2 = last ? nA : cA + (size_t)(t + 2) * kstep; const char* b2 = last ? nB : cB + (size_t)(t + 2) * kstep;
            const char* a3 = a2 + kstep; const char* b3 = b2 + kstep;
            if constexpr (Epi::HAS_MID) { if (t == nt / 2) E.mid(acc, wr, fr, ui, lds); }
            PG8_LDB(B0, 0, 0); PG8_LDB(B1, 0, 1); PG8_SCHED; PG8_LDA(At, 0, 0); PG8_STAGE(PG8_SA(1, 1), a1 + hstepA, voffA);
            PG8_WAIT_V(8); PG8_WAIT_L(0); PG8_BAR; PG8_MMA(0, 0, At, B0); PG8_MMA(0, 1, At, B1); PG8_BAR; PG8_SCHED;
            PG8_LDA(At, 0, 1); PG8_STAGE(PG8_SB(0, 0), b2, voffB); PG8_STAGE(PG8_SB(0, 1), b2 + hstepB, voffB); PG8_STAGE(PG8_SA(0, 0), a2, voffA);
            PG8_WAIT_V(8); PG8_WAIT_L(0); PG8_BAR; PG8_MMA(1, 0, At, B0); PG8_MMA(1, 1, At, B1); PG8_BAR; PG8_SCHED;
            PG8_LDB(B0, 1, 0); PG8_LDB(B1, 1, 1); PG8_SCHED; PG8_LDA(At, 1, 0); PG8_STAGE(PG8_SA(0, 1), a2 + hstepA, voffA);
            PG8_WAIT_V(8); PG8_WAIT_L(0); PG8_BAR; PG8_MMA(0, 0, At, B0); PG8_MMA(0, 1, At, B1); PG8_BAR; PG8_SCHED;
            PG8_LDA(At, 1, 1); PG8_STAGE(PG8_SB(1, 0), b3, voffB); PG8_STAGE(PG8_SB(1, 1), b3 + hstepB, voffB); PG8_STAGE(PG8_SA(1, 0), a3, voffA);
            PG8_WAIT_V(8); PG8_WAIT_L(0); PG8_BAR; PG8_MMA(1, 0, At, B0); PG8_MMA(1, 1, At, B1); PG8_BAR; PG8_SCHED;
        }
        if (wr == 0) PG8_BAR;
        E(acc, cur, wr, wc, fr, fq, ui, lds);
        if (!has_next) break;
#pragma unroll
        for (int a = 0; a < 2; ++a)
#pragma unroll
            for (int b = 0; b < 2; ++b)
#pragma unroll
                for (int m = 0; m < 4; ++m)
#pragma unroll
                    for (int n = 0; n < 2; ++n) acc[a][b][m][n] = (f32x4){0.f, 0.f, 0.f, 0.f};
        cur = nxt; cA = nA; cB = nB; ++ui;
        E.begin(cur, ui, tid, lds);
        if (wr == 1) PG8_BAR;
    }
    PG8_WAIT_V(0);
    PG8_BAR;
#undef PG8_SA
#undef PG8_SB
#undef PG8_STAGE
#undef PG8_LDA
#undef PG8_LDB
#undef PG8_MMA
#undef PG8_WAIT_V
#undef PG8_WAIT_L
#undef PG8_BAR
#undef PG8_SCHED
}
}

typedef const f32x4 (&AccRef)[2][2][4][2];

struct EpiP1 {
    static constexpr bool HAS_MID = false;
    P p;
    DEVI void begin(const pg8::Unit&, int, int, PG8_LAS unsigned char*) const {}
    DEVI void mid(f32x4 (&)[2][2][4][2], int, int, int, PG8_LAS unsigned char*) const {}
    DEVI void operator()(AccRef acc, const pg8::Unit& u, int wr, int wc, int fr, int fq, int, PG8_LAS unsigned char*) const {
        const float* rs = (const float*)(p.ws + W_RS);
        const int pn = u.pn;
        const int kind = pn < 2 ? 0 : (pn == 2 ? (wc < 2 ? 1 : 2) : (pn < 5 ? 3 : (pn < 7 ? 4 : 5)));
        if (kind <= 1) {
            const float* nw = kind == 0 ? p.q_norm_w : p.k_norm_w;
            f32x4 w4[2][2];
#pragma unroll
            for (int bj = 0; bj < 2; ++bj)
#pragma unroll
                for (int n = 0; n < 2; ++n) w4[bj][n] = *(const f32x4*)(nw + 32 * bj + 8 * fq + 4 * n);
            const float2* rope = (const float2*)(p.ws + W_ROPE);
#pragma unroll
            for (int ai = 0; ai < 2; ++ai)
#pragma unroll
                for (int m = 0; m < 4; ++m) {
                    const int row = u.pm * 256 + ai * 128 + wr * 64 + m * 16 + fr;
                    const float rsv = rs[row];
                    const bool isp = row < NPR; const int b = row >= LP ? 1 : 0;
                    const int pos = isp ? row - b * LP : 8192 + ((row - NPR) & 7);
                    float v[2][2][4]; float ss = 0.f;
#pragma unroll
                    for (int bj = 0; bj < 2; ++bj)
#pragma unroll
                        for (int n = 0; n < 2; ++n)
#pragma unroll
                            for (int j = 0; j < 4; ++j) { v[bj][n][j] = acc[ai][bj][m][n][j] * rsv; ss += v[bj][n][j] * v[bj][n][j]; }
                    ss += __shfl_xor(ss, 16); ss += __shfl_xor(ss, 32);
                    const float rinv = rsqrtf(ss * (1.f / 64.f) + EPS);
                    const int rpos = pos < LP ? pos : LP - 1;
#pragma unroll
                    for (int n = 0; n < 2; ++n) {
                        const f32x4 cs0 = *(const f32x4*)(rope + (size_t)rpos * 32 + 8 * fq + 4 * n);
                        const f32x4 cs1 = *(const f32x4*)(rope + (size_t)rpos * 32 + 8 * fq + 4 * n + 2);
                        const float c[4] = {cs0[0], cs0[2], cs1[0], cs1[2]}, s[4] = {cs0[1], cs0[3], cs1[1], cs1[3]};
#pragma unroll
                        for (int j = 0; j < 4; ++j) { const float x1 = v[0][n][j] * rinv * w4[0][n][j], x2 = v[1][n][j] * rinv * w4[1][n][j];
                            v[0][n][j] = x1 * c[j] - x2 * s[j]; v[1][n][j] = x2 * c[j] + x1 * s[j]; }
                    }
                    if (kind == 0) {
                        if (row < NROWS) { bf16_t* qb = (bf16_t*)(p.ws + W_QB) + (size_t)row * 512 + (pn * 4 + wc) * 64 + 8 * fq;
#pragma unroll
                            for (int bj = 0; bj < 2; ++bj) { u32x4 w = {pk2(v[bj][0][0] * QSCALE, v[bj][0][1] * QSCALE), pk2(v[bj][0][2] * QSCALE, v[bj][0][3] * QSCALE), pk2(v[bj][1][0] * QSCALE, v[bj][1][1] * QSCALE), pk2(v[bj][1][2] * QSCALE, v[bj][1][3] * QSCALE)};
                                *(u32x4*)(qb + 32 * bj) = w; } }
                    } else {
                        const int kvh = wc;
                        if (row < NROWS) {
                            const int blk = isp ? b * 257 + (pos >> 5) : 514 + ((row - NPR) >> 3) * 5 + 4, key = isp ? (pos & 31) : ((row - NPR) & 7);
                            bf16_t* kF = (bf16_t*)(p.ws + W_KF);
#pragma unroll
                            for (int bj = 0; bj < 2; ++bj) { u32x4 w = {pk2(v[bj][0][0], v[bj][0][1]), pk2(v[bj][0][2], v[bj][0][3]), pk2(v[bj][1][0], v[bj][1][1]), pk2(v[bj][1][2], v[bj][1][3])};
                                *(u32x4*)(kF + ((size_t)((kvh * NBLK + blk) * 4 + 2 * bj + (fq >> 1)) * 64 + (fq & 1) * 32 + key) * 8) = w; }
                        }
                        if (isp) {
                            if (pos >= LP - 128) { float* o = p.out + O_KWP + ((size_t)(b * 128 + pos - (LP - 128)) * 2 + kvh) * 64 + 8 * fq;
#pragma unroll
                                for (int bj = 0; bj < 2; ++bj)
#pragma unroll
                                    for (int n = 0; n < 2; ++n) *(f32x4*)(o + 32 * bj + 4 * n) = (f32x4){v[bj][n][0], v[bj][n][1], v[bj][n][2], v[bj][n][3]}; }
                        } else if (row < NROWS) { float* o = p.out + O_KNS + ((size_t)(row - NPR) * 2 + kvh) * 64 + 8 * fq;
#pragma unroll
                            for (int bj = 0; bj < 2; ++bj)
#pragma unroll
                                for (int n = 0; n < 2; ++n) *(f32x4*)(o + 32 * bj + 4 * n) = (f32x4){v[bj][n][0], v[bj][n][1], v[bj][n][2], v[bj][n][3]}; }
                    }
                    asm volatile("" ::: "memory");
                }
        } else if (kind == 2) {
            const int kvh = wc - 2;
#pragma unroll
            for (int ai = 0; ai < 2; ++ai)
#pragma unroll
                for (int m = 0; m < 4; ++m) {
                    const int row = u.pm * 256 + ai * 128 + wr * 64 + m * 16 + fr;
                    const float rsv = rs[row];
                    const bool isp = row < NPR; const int b = row >= LP ? 1 : 0;
                    const int pos = isp ? row - b * LP : 0;
                    if (row < NROWS) {
                        const int blk = isp ? b * 257 + (pos >> 5) : 514 + ((row - NPR) >> 3) * 5 + 4, kk = isp ? (pos & 31) : ((row - NPR) & 7), s2 = kk >> 4, r16 = kk & 15, jj = (r16 >> 3) * 4 + (r16 & 3), hh = (r16 >> 2) & 1;
                        bf16_t* vF = (bf16_t*)(p.ws + W_VF);
#pragma unroll
                        for (int bj = 0; bj < 2; ++bj)
#pragma unroll
                            for (int n = 0; n < 2; ++n)
#pragma unroll
                                for (int j = 0; j < 4; ++j)
                                    vF[((size_t)(((kvh * NBLK + blk) * 2 + bj) * 2 + s2) * 64 + hh * 32 + (8 * fq + 4 * n + j)) * 8 + jj] = f2bf(acc[ai][bj][m][n][j] * rsv);
                    }
                    if (isp) {
                        if (pos >= LP - 128) { float* o = p.out + O_VWP + ((size_t)(b * 128 + pos - (LP - 128)) * 2 + kvh) * 64 + 8 * fq;
#pragma unroll
                            for (int bj = 0; bj < 2; ++bj)
#pragma unroll
                                for (int n = 0; n < 2; ++n) *(f32x4*)(o + 32 * bj + 4 * n) = acc[ai][bj][m][n] * rsv; }
                    } else if (row < NROWS) { float* o = p.out + O_VNS + ((size_t)(row - NPR) * 2 + kvh) * 64 + 8 * fq;
#pragma unroll
                        for (int bj = 0; bj < 2; ++bj)
#pragma unroll
                            for (int n = 0; n < 2; ++n) *(f32x4*)(o + 32 * bj + 4 * n) = acc[ai][bj][m][n] * rsv; }
                    asm volatile("" ::: "memory");
                }
        } else if (kind == 4) {
            bf16_t* uG = (bf16_t*)(p.ws + W_UG);
#pragma unroll
            for (int ai = 0; ai < 2; ++ai)
#pragma unroll
                for (int m = 0; m < 4; ++m) {
                    const int row = u.pm * 256 + ai * 128 + wr * 64 + m * 16 + fr;
                    const float rsv = rs[row];
                    if (row < NROWS) {
#pragma unroll
                        for (int bj = 0; bj < 2; ++bj) { const int g = (pn - 5) * 16 + 4 * wc + 2 * bj + (fq >> 1); const f32x4 t0 = acc[ai][bj][m][0] * rsv, t1 = acc[ai][bj][m][1] * rsv;
                            u32x4 w = {pk2(t0[0], t0[1]), pk2(t0[2], t0[3]), pk2(t1[0], t1[1]), pk2(t1[2], t1[3])}; *(u32x4*)(uG + ((size_t)g * NROWS_PAD + row) * 16 + 8 * (fq & 1)) = w; }
                    }
                }
        } else {
            bf16_t* dst0 = (bf16_t*)(p.ws + (kind == 3 ? W_GA : W_GS)) + (kind == 3 ? pn - 3 : pn - 7) * 256 + 64 * wc + 8 * fq;
#pragma unroll
            for (int ai = 0; ai < 2; ++ai)
#pragma unroll
                for (int m = 0; m < 4; ++m) {
                    const int row = u.pm * 256 + ai * 128 + wr * 64 + m * 16 + fr;
                    const float rsv = rs[row];
                    if (row < NROWS) {
                        const int rowd = kind == 3 ? row : row3_of(row);
#pragma unroll
                        for (int bj = 0; bj < 2; ++bj) { const f32x4 t0 = acc[ai][bj][m][0] * rsv, t1 = acc[ai][bj][m][1] * rsv;
                            u32x4 w = {pk2(t0[0], t0[1]), pk2(t0[2], t0[3]), pk2(t1[0], t1[1]), pk2(t1[2], t1[3])}; *(u32x4*)(dst0 + (size_t)rowd * 512 + 32 * bj) = w; }
                    }
                }
        }
    }
};

struct EpiGlu {
    static constexpr bool HAS_MID = false;
    P p;
    DEVI void begin(const pg8::Unit&, int, int, PG8_LAS unsigned char*) const {}
    DEVI void mid(f32x4 (&)[2][2][4][2], int, int, int, PG8_LAS unsigned char*) const {}
    DEVI void operator()(AccRef acc, const pg8::Unit& u, int wr, int wc, int fr, int fq, int, PG8_LAS unsigned char*) const {
        const bf16_t* gB = gb_base(p.ws, u.pm >= 64); const bf16_t* gs = (const bf16_t*)(p.ws + W_GS);
        bf16_t* cat = (bf16_t*)(p.ws + W_CAT); float* ssqs = (float*)(p.ws + W_SSQS);
        const int f0 = u.pn * 256 + 32 * wc + 8 * fq;
        f32x4 bg[2][2];
#pragma unroll
        for (int bj = 0; bj < 2; ++bj)
#pragma unroll
            for (int n = 0; n < 2; ++n) bg[bj][n] = *(const f32x4*)(p.b_glu + f0 + 128 * bj + 4 * n);
#pragma unroll
        for (int ai = 0; ai < 2; ++ai)
#pragma unroll
            for (int m = 0; m < 4; ++m) {
                const int row = u.pm * 256 + ai * 128 + wr * 64 + m * 16 + fr;
                float ssq = 0.f;
#pragma unroll
                for (int bj = 0; bj < 2; ++bj) {
                    const int f = f0 + 128 * bj;
                    const u32x4 gw = *(const u32x4*)(gB + (size_t)row * 512 + f), sw = *(const u32x4*)(gs + (size_t)row * 512 + f);
                    float s[8];
#pragma unroll
                    for (int n = 0; n < 2; ++n)
#pragma unroll
                        for (int j = 0; j < 4; ++j) { const unsigned gwd = gw[2 * n + (j >> 1)], swd = sw[2 * n + (j >> 1)];
                            const float gl = (j & 1) ? bfhi(gwd) : bflo(gwd), gv = (j & 1) ? bfhi(swd) : bflo(swd);
                            s[4 * n + j] = gl * sigmoid_f(acc[ai][bj][m][n][j] + bg[bj][n][j]) * silu_f(gv); ssq += s[4 * n + j] * s[4 * n + j]; }
                    { u32x4 w = {pk2(s[0], s[1]), pk2(s[2], s[3]), pk2(s[4], s[5]), pk2(s[6], s[7])}; *(u32x4*)(cat + (size_t)row * 1024 + 512 + f) = w; }
                }
                ssq += __shfl_xor(ssq, 16); ssq += __shfl_xor(ssq, 32);
                if (fq == 0) ssqs[(size_t)row * 8 + u.pn * 4 + wc] = ssq;
                asm volatile("" ::: "memory");
            }
    }
};

constexpr int LDS_TAB = 131072;
struct EpiOut {
    static constexpr bool HAS_MID = true;
    P p;
    DEVI void begin(const pg8::Unit& u, int ui, int tid, PG8_LAS unsigned char* lds) const {
        if (tid < 256) {
            const int row = u.pm * 256 + tid;
            float ra = 1.f, rsv = 1.f;
            {
                const float* ssqa = (const float*)(p.ws + W_SSQA) + (size_t)row * 8; const float* ssqs = (const float*)(p.ws + W_SSQS) + (size_t)row * 8;
                const f32x4 a0 = *(const f32x4*)(ssqa), a1 = *(const f32x4*)(ssqa + 4), s0 = *(const f32x4*)(ssqs), s1 = *(const f32x4*)(ssqs + 4);
                ra = rsqrtf(((a0[0] + a0[1]) + (a0[2] + a0[3]) + (a1[0] + a1[1]) + (a1[2] + a1[3])) * (1.f / 512.f) + EPS);
                rsv = rsqrtf(((s0[0] + s0[1]) + (s0[2] + s0[3]) + (s1[0] + s1[1]) + (s1[2] + s1[3])) * (1.f / 512.f) + EPS);
            }
            ((PG8_LAS f32x2*)(lds + LDS_TAB))[(ui & 1) * 256 + tid] = (f32x2){ra / rsv, rsv};
        }
    }
    DEVI void mid(f32x4 (&acc)[2][2][4][2], int wr, int fr, int ui, PG8_LAS unsigned char* lds) const {
#pragma unroll
        for (int ai = 0; ai < 2; ++ai)
#pragma unroll
            for (int m = 0; m < 4; ++m) {
                const float sc = ((const PG8_LAS f32x2*)(lds + LDS_TAB))[(ui & 1) * 256 + ai * 128 + wr * 64 + m * 16 + fr].x;
#pragma unroll
                for (int bj = 0; bj < 2; ++bj)
#pragma unroll
                    for (int n = 0; n < 2; ++n) acc[ai][bj][m][n] *= sc;
            }
    }
    DEVI void operator()(AccRef acc, const pg8::Unit& u, int wr, int wc, int fr, int fq, int ui, PG8_LAS unsigned char* lds) const {
#pragma unroll
        for (int ai = 0; ai < 2; ++ai)
#pragma unroll
            for (int m = 0; m < 4; ++m) {
                const int rl = ai * 128 + wr * 64 + m * 16 + fr, row = u.pm * 256 + rl;
                const float rsv = ((const PG8_LAS f32x2*)(lds + LDS_TAB))[(ui & 1) * 256 + rl].y;
                const float* xr; float* yo;
                if (row < 16384) { const size_t o = (size_t)row * 1024; xr = p.x_prompt + o; yo = p.out + O_YP + o; }
                else { const size_t o = (size_t)(row - 16384) * 1024; xr = p.x_sample + o; yo = p.out + O_YS + o; }
                {
#pragma unroll
                    for (int bj = 0; bj < 2; ++bj)
#pragma unroll
                        for (int n = 0; n < 2; ++n) { const int f = u.pn * 256 + 128 * bj + 32 * wc + 8 * fq + 4 * n;
                            const f32x4 xv = *(const f32x4*)(xr + f); *(f32x4*)(yo + f) = xv + acc[ai][bj][m][n] * rsv; }
                }
                asm volatile("" ::: "memory");
            }
    }
};

DEVI void phase1(const P& p, PG8_LAS unsigned char* lds) {
    pg8::Gemm g{(const bf16_t*)(p.ws + W_XB), (const bf16_t*)(p.ws + W_WINT), 1024, 1024, 1024};
    pg8::StaticOrder S; S.init(NROWS_PAD, 2304, gridDim.x, blockIdx.x);
    EpiP1 E{p};
    pg8::gemm_phase<EpiP1, pg8::StaticOrder>(lds, g, S, E);
    const int n3 = 621 - 2 * (int)gridDim.x;
    if ((int)blockIdx.x >= n3) deferred_prep(p, ((int)blockIdx.x - n3) * 512 + tidx(), ((int)gridDim.x - n3) * 512);
}
template <bool FIRST>
struct EpiOutHalf {
    static constexpr bool HAS_MID = false;
    P p;
    DEVI void begin(const pg8::Unit& u, int ui, int tid, PG8_LAS unsigned char* lds) const {
        if (tid < 256) {
            const int row = u.pm * 256 + tid;
            const float* ssq = (const float*)(p.ws + (FIRST ? W_SSQA : W_SSQS)) + (size_t)row * 8;
            const f32x4 a0 = *(const f32x4*)(ssq), a1 = *(const f32x4*)(ssq + 4);
            ((PG8_LAS float*)(lds + LDS_TAB))[(ui & 1) * 256 + tid] = rsqrtf(((a0[0] + a0[1]) + (a0[2] + a0[3]) + (a1[0] + a1[1]) + (a1[2] + a1[3])) * (1.f / 512.f) + EPS);
        }
    }
    DEVI void mid(f32x4 (&)[2][2][4][2], int, int, int, PG8_LAS unsigned char*) const {}
    DEVI void operator()(AccRef acc, const pg8::Unit& u, int wr, int wc, int fr, int fq, int ui, PG8_LAS unsigned char* lds) const {
#pragma unroll
        for (int ai = 0; ai < 2; ++ai)
#pragma unroll
            for (int m = 0; m < 4; ++m) {
                const int rl = ai * 128 + wr * 64 + m * 16 + fr, row = u.pm * 256 + rl;
                const float rsv = ((const PG8_LAS float*)(lds + LDS_TAB))[(ui & 1) * 256 + rl];
                const size_t o = (size_t)(row - 16384) * 1024; const float* xr = p.x_sample + o; float* yo = p.out + O_YS + o;
#pragma unroll
                for (int bj = 0; bj < 2; ++bj)
#pragma unroll
                    for (int n = 0; n < 2; ++n) { const int f = u.pn * 256 + 128 * bj + 32 * wc + 8 * fq + 4 * n;
                        const f32x4 base = FIRST ? *(const f32x4*)(xr + f) : *(const f32x4*)(yo + f); *(f32x4*)(yo + f) = base + acc[ai][bj][m][n] * rsv; }
                asm volatile("" ::: "memory");
            }
    }
};
struct SchedOne { int pm, pn; DEVI bool next(int i, pg8::Unit& u) const { if (i != 0) return false; u.pm = pm; u.pn = pn; return true; } };
DEVI void glu_unit(const P& p, PG8_LAS unsigned char* lds, int pm, int pn) {
    pg8::Gemm g{gb_base(p.ws, pm >= 64), (const bf16_t*)(p.ws + W_WGLUT), 512, 512, 512}; SchedOne S{pm, pn}; EpiGlu E{p};
    pg8::gemm_phase<EpiGlu, SchedOne>(lds, g, S, E);
}
DEVI void out_unit(const P& p, PG8_LAS unsigned char* lds, int pm, int pn) {
    pg8::Gemm g{(const bf16_t*)(p.ws + W_CAT), (const bf16_t*)(p.ws + W_WOUTT), 1024, 1024, 1024}; SchedOne S{pm, pn}; EpiOut E{p};
    pg8::gemm_phase<EpiOut, SchedOne>(lds, g, S, E);
}
template <bool FIRST>
DEVI void out_half_unit(const P& p, PG8_LAS unsigned char* lds, int pm, int pn) {
    pg8::Gemm g{(const bf16_t*)(p.ws + W_CAT) + (FIRST ? 0 : 512), (const bf16_t*)(p.ws + W_WOUTT) + (FIRST ? 0 : 512), 1024, 1024, 512}; SchedOne S{pm, pn}; EpiOutHalf<FIRST> E{p};
    pg8::gemm_phase<EpiOutHalf<FIRST>, SchedOne>(lds, g, S, E);
}
DEVI void phase2b_gemm(const P& p, PG8_LAS unsigned char* lds) {
    const int c = blockIdx.x;
    if (c >= 248) glu_unit(p, lds, 64 + ((c - 248) >> 1), (c - 248) & 1);
    else out_half_unit<true>(p, lds, 64 + ((c - 232) >> 2), (c - 232) & 3);
}
DEVI void phase3a(const P& p, PG8_LAS unsigned char* lds) {
    const int c = blockIdx.x;
    if (c < 128) { const int x = c & 7, s = c >> 3; glu_unit(p, lds, x * 8 + (s >> 1), s & 1); }
    else if (c < 144) out_half_unit<false>(p, lds, 64 + ((c - 128) >> 2), (c - 128) & 3);
}
DEVI void phase3b(const P& p, PG8_LAS unsigned char* lds) { const int c = blockIdx.x, x = c & 7, s = c >> 3; out_unit(p, lds, x * 8 + (s >> 2), s & 3); }

__global__ void __launch_bounds__(512, 2) hymba_fwd(P p) {
    extern __shared__ __attribute__((aligned(16))) unsigned char lds_dyn[];
    PG8_LAS unsigned char* lds = (PG8_LAS unsigned char*)lds_dyn;
    if (threadIdx.x < 16) ((PG8_LAS unsigned*)(lds + LDS_XB))[threadIdx.x] = 0u;
    __syncthreads();
    XcdBarrier xb = xcd_barrier_post((unsigned*)(p.ws + W_BAR), (volatile LAS unsigned*)(lds + LDS_XB));
#ifndef REP0
#define REP0 1
#define REP1 1
#define REP2A 1
#define REP2B 1
#define REP3A 1
#define REP3B 1
#endif
    for (int r = 0; r < REP0; ++r) { phase0(p); xcd_barrier(xb); }
    for (int r = 0; r < REP1; ++r) { phase1(p, lds); xcd_barrier(xb); }
    for (int r = 0; r < REP2A; ++r) { phase2a(p, (char*)lds_dyn); xcd_barrier(xb); }
    if (blockIdx.x < 232) phase2b(p, (char*)lds_dyn); else phase2b_gemm(p, lds);
    xcd_barrier(xb);
    for (int r = 0; r < REP3A; ++r) { phase3a(p, lds); xcd_barrier(xb); }
    for (int r = 0; r < REP3B; ++r) { phase3b(p, lds); if (r + 1 < REP3B) xcd_barrier(xb); }
}

extern "C" void kernel_launch(void* const* d_in, const int* in_sizes, int n_in, void* d_out, int out_size, void* d_ws, size_t ws_size, hipStream_t stream) {
    P p{};
    const float** pp = (const float**)&p;
    for (int i = 0; i < 25; ++i) pp[i] = (const float*)d_in[i];
    p.out = (float*)d_out; p.ws = (char*)d_ws;
    static int grid_blocks = 0;
    if (!grid_blocks) {
        int dev = 0, cus = 0, per_cu = 0;
        (void)hipGetDevice(&dev);
        (void)hipDeviceGetAttribute(&cus, hipDeviceAttributeMultiprocessorCount, dev);
        (void)hipFuncSetAttribute((const void*)hymba_fwd, hipFuncAttributeMaxDynamicSharedMemorySize, LDS_BYTES);
        (void)hipOccupancyMaxActiveBlocksPerMultiprocessor(&per_cu, hymba_fwd, 512, LDS_BYTES);
        if (per_cu < 1) fprintf(stderr, "occupancy query reports %d blocks per CU\n", per_cu);
        grid_blocks = cus;
    }
    (void)hipMemsetAsync((char*)d_ws + W_BAR, 0, 16384, stream);
    void* args[] = {&p};
    hipError_t e = hipLaunchCooperativeKernel((void*)hymba_fwd, dim3(grid_blocks), dim3(512), args, LDS_BYTES, stream);
    if (e != hipSuccess) fprintf(stderr, "cooperative launch failed: %s (grid %d)\n", hipGetErrorString(e), grid_blocks);
}
```

```cpp
#include <hip/hip_runtime.h>
#include <hip/hip_cooperative_groups.h>
#include <cstdio>
#include <cstdint>
namespace cg = cooperative_groups;

#ifndef SINGLE_LAUNCH
#define SINGLE_LAUNCH 1
#endif

#define DEVI __device__ __forceinline__
typedef unsigned short bf16_t;
typedef short bf16x8 __attribute__((ext_vector_type(8)));
typedef float f32x4 __attribute__((ext_vector_type(4)));
typedef float f32x16 __attribute__((ext_vector_type(16)));
typedef unsigned u32x2 __attribute__((ext_vector_type(2)));
typedef float f32x2 __attribute__((ext_vector_type(2)));
typedef unsigned u32x4 __attribute__((ext_vector_type(4)));

constexpr int LP = 8208;
constexpr int NPR = 2 * LP;
constexpr int NROWS = NPR + 1024;
constexpr int NROWS_PAD = 17664;
constexpr int NBLK = 514 + 640;
constexpr float EPS = 1e-6f;
constexpr float LOG2E = 1.4426950408889634f;
constexpr float QSCALE = 0.125f * LOG2E;

constexpr size_t O_YP = 0, O_YS = 16777216, O_KWP = 17825792, O_VWP = 17858560, O_SRP = 17891328, O_SIP = 17895424,
                 O_KNS = 17899520, O_VNS = 18030592, O_SRS = 18161664, O_SIS = 18423808;

constexpr size_t al256(size_t x) { return (x + 255) & ~(size_t)255; }
constexpr size_t W_BAR = 0;
constexpr size_t W_XB = 16384;
constexpr size_t W_RS = al256(W_XB + (size_t)NROWS_PAD * 1024 * 2);
constexpr size_t W_WINT = al256(W_RS + (size_t)NROWS_PAD * 4);
constexpr size_t W_WGLUT = al256(W_WINT + (size_t)2304 * 1024 * 2);
constexpr size_t W_WOUTT = al256(W_WGLUT + (size_t)512 * 512 * 2);
constexpr size_t W_ROPE = al256(W_WOUTT + (size_t)1024 * 1024 * 2);
constexpr size_t W_LAM = al256(W_ROPE + (size_t)LP * 32 * 8);
constexpr size_t W_LAM64 = al256(W_LAM + 32 * 64 * 8);
constexpr size_t W_BBARF = al256(W_LAM64 + 32 * 64 * 8);
constexpr size_t W_CMF = al256(W_BBARF + 32 * 4 * 64 * 8 * 2);
constexpr size_t W_QB = al256(W_CMF + 32 * 4 * 64 * 8 * 2);
constexpr size_t W_KF = al256(W_QB + (size_t)NROWS_PAD * 512 * 2);
constexpr size_t W_VF = al256(W_KF + (size_t)2 * NBLK * 4 * 64 * 8 * 2);
constexpr size_t W_GA = al256(W_VF + (size_t)2 * NBLK * 4 * 64 * 8 * 2);
constexpr size_t W_GS = al256(W_GA + (size_t)NROWS_PAD * 512 * 2);
constexpr size_t W_UG = al256(W_GS + (size_t)NROWS_PAD * 512 * 2);
constexpr size_t W_CAT = W_XB;
constexpr size_t W_SSQA = al256(W_UG + (size_t)NROWS_PAD * 512 * 2);
constexpr size_t W_GB = W_QB;
constexpr size_t W_GBS = al256(W_SSQA + (size_t)NROWS_PAD * 8 * 4);
constexpr size_t W_SSQS = al256(W_GBS + (size_t)1024 * 512 * 2);
DEVI bf16_t* gb_base(char* ws, bool sample_rows) { return sample_rows ? (bf16_t*)(ws + W_GBS) - (size_t)16384 * 512 : (bf16_t*)(ws + W_GB); }
constexpr size_t W_ENDS = al256(W_SSQS + (size_t)NROWS_PAD * 8 * 4);
constexpr size_t W_CARRY = al256(W_ENDS + (size_t)2 * 32 * 128 * 64 * 8);
constexpr size_t W_TOTAL = al256(W_CARRY + (size_t)2 * 32 * 129 * 64 * 8);

constexpr int LDS_XB = 131072 + 4096;
constexpr int LDS_BYTES = LDS_XB + 64;

struct P {
    const float *x_prompt, *x_sample, *cache_k, *cache_v, *st_re, *st_im, *meta, *norm_w, *w_in, *q_norm_w, *k_norm_w, *sinks,
        *aon_w, *A_re, *A_im, *log_dt, *B_re, *B_im, *C_re, *C_im, *Dk, *w_glu, *b_glu, *son_w, *w_out;
    float* out;
    char* ws;
};

DEVI int tidx() { int t = threadIdx.x; asm volatile("" : "+v"(t)); return t; }
constexpr int NROWS3 = 17408;
DEVI int row3_of(int row) {
    if (row >= NPR) return 16384 + (row - NPR);
    const int b = row >= LP ? 1 : 0, pos = row - b * LP;
    return pos >= 16 ? b * 8192 + pos - 16 : NROWS3 + b * 16 + pos;
}
typedef __bf16 bf16x2_t __attribute__((ext_vector_type(2)));
DEVI unsigned pk2(float lo, float hi) { const f32x2 v = {lo, hi}; const bf16x2_t b = __builtin_convertvector(v, bf16x2_t); return __builtin_bit_cast(unsigned, b); }
DEVI bf16_t f2bf(float f) { return (bf16_t)(pk2(f, 0.f) & 0xffffu); }
DEVI float bf2f(unsigned short b) { return __uint_as_float(((unsigned)b) << 16); }
DEVI float bflo(unsigned w) { return __uint_as_float(w << 16); }
DEVI float bfhi(unsigned w) { return __uint_as_float(w & 0xffff0000u); }
DEVI float silu_f(float x) { return x * __builtin_amdgcn_rcpf(1.f + __expf(-x)); }
DEVI float sigmoid_f(float x) { return __builtin_amdgcn_rcpf(1.f + __expf(-x)); }
DEVI float gelu_tanh(float x) {
    const float u = 1.5957691216057308f * (x + 0.044715f * x * x * x);
    return x * __builtin_amdgcn_rcpf(1.f + __expf(-u));
}
DEVI f32x4 mfma16(bf16x8 a, bf16x8 b, f32x4 c) { return __builtin_amdgcn_mfma_f32_16x16x32_bf16(a, b, c, 0, 0, 0); }
DEVI f32x16 mfma32(bf16x8 a, bf16x8 b, f32x16 c) { return __builtin_amdgcn_mfma_f32_32x32x16_bf16(a, b, c, 0, 0, 0); }
DEVI bf16x8 mk8(unsigned a, unsigned b, unsigned c, unsigned d) { u32x4 t = {a, b, c, d}; return __builtin_bit_cast(bf16x8, t); }


#define XB_TMO      128
#define XB_XCNT(j)  (256  + 64 * (j))
#define XB_XSUB(j)  (1280 + 64 * (j))
#define XB_XGEN(j)  (2304 + 64 * (j))
#define XB_TOP      3328
#define XB_TOPGEN   3392
#define XCD_BAR_WORDS 3456
#define XB_SPIN_CAP (1u << 18)
#define LAS __attribute__((address_space(3)))
DEVI unsigned xb_ld(unsigned* p) { return __hip_atomic_load(p, __ATOMIC_RELAXED, __HIP_MEMORY_SCOPE_AGENT); }
DEVI unsigned xb_add(unsigned* p, unsigned v) { return __hip_atomic_fetch_add(p, v, __ATOMIC_RELAXED, __HIP_MEMORY_SCOPE_AGENT); }
DEVI unsigned xb_xcc_id() { return (unsigned)__builtin_amdgcn_s_getreg((3 << 11) | 20) & 0xFu; }
#define XB_SPIN(cond, bar) do { unsigned _sp = 0; while (cond) { __builtin_amdgcn_s_sleep(1); \
    if ((++_sp & 255u) == 0u) { if (xb_ld(&(bar)[XB_TMO])) break; if (_sp > XB_SPIN_CAP) { atomicAdd(&(bar)[XB_TMO], 1u); break; } } } } while (0)
struct XcdBarrier { unsigned* bar; unsigned x; volatile LAS unsigned* st; };
DEVI XcdBarrier xcd_barrier_post(unsigned* bar, volatile LAS unsigned* st) {
    XcdBarrier b; b.bar = bar; b.x = xb_xcc_id(); b.st = st;
    if (tidx() == 0) (void)xb_add(&bar[XB_XCNT(b.x)], 1u);
    return b;
}
DEVI void xcd_barrier_complete(unsigned* bar, unsigned x, unsigned& nloc, unsigned& nx) {
    const unsigned G = gridDim.x * gridDim.y * gridDim.z;
    unsigned sum, cnt, mine, sp = 0u;
    for (;;) {
        sum = 0u; cnt = 0u; mine = 0u;
#pragma unroll
        for (unsigned j = 0; j < 16; ++j) { const unsigned c = xb_ld(&bar[XB_XCNT(j)]); sum += c; cnt += (c > 0u) ? 1u : 0u; mine = (j == x) ? c : mine; }
        if (sum == G) break;
        __builtin_amdgcn_s_sleep(1);
        if ((++sp & 255u) == 0u) { if (xb_ld(&bar[XB_TMO])) break; if (sp > XB_SPIN_CAP) { atomicAdd(&bar[XB_TMO], 1u); break; } }
    }
    nloc = mine > 0u ? mine : 1u; nx = cnt > 0u ? cnt : 1u;
}
DEVI void xcd_barrier(const XcdBarrier& b) {
    asm volatile("s_waitcnt vmcnt(0)" ::: "memory");
    __syncthreads();
    if (tidx() == 0) {
        unsigned* bar = b.bar;
        __builtin_amdgcn_s_waitcnt(0);
        unsigned nloc = b.st[0], nx = b.st[1];
        if (nloc == 0u) { xcd_barrier_complete(bar, b.x, nloc, nx); b.st[0] = nloc; b.st[1] = nx; }
        const unsigned old = xb_add(&bar[XB_XSUB(b.x)], 1u);
        const unsigned gen = old / nloc;
        if (old + 1u == (gen + 1u) * nloc) {
            __builtin_amdgcn_fence(__ATOMIC_RELEASE, "agent");
            asm volatile("s_waitcnt vmcnt(0)" ::: "memory");
            const unsigned og = xb_add(&bar[XB_TOP], 1u);
            const unsigned tg = og / nx;
            if (og + 1u == (tg + 1u) * nx) xb_add(&bar[XB_TOPGEN], 1u);
            else XB_SPIN(xb_ld(&bar[XB_TOPGEN]) == tg, bar);
            __builtin_amdgcn_fence(__ATOMIC_ACQUIRE, "agent");
            xb_add(&bar[XB_XGEN(b.x)], 1u);
            asm volatile("s_waitcnt vmcnt(0)" ::: "memory");
        } else {
            XB_SPIN(xb_ld(&bar[XB_XGEN(b.x)]) == gen, bar);
            __builtin_amdgcn_fence(__ATOMIC_ACQUIRE, "agent");
            asm volatile("s_waitcnt vmcnt(0)" ::: "memory");
        }
    }
    __syncthreads();
}

DEVI const float* row_src(const P& p, int r) {
    if (r < NPR) { const int b = r >= LP ? 1 : 0, pos = r - b * LP; return pos < 16 ? p.meta + (size_t)pos * 1024 : p.x_prompt + ((size_t)b * 8192 + pos - 16) * 1024; }
    if (r < NROWS) return p.x_sample + (size_t)(r - NPR) * 1024;
    return nullptr;
}

DEVI void p0_ssm_f(const P& p, int i, float& fre, float& fim, float2& lamv, float2& lam64v) {
    const int g = i >> 6;
    const double dt = exp((double)p.log_dt[g]), are = p.A_re[i], aim = p.A_im[i];
    const double mag = exp(dt * are);
    double th = dt * aim * 0.15915494309189535; th -= rint(th); th *= 6.283185307179586;
    const float thf = (float)th; const float sh = sinf(0.5f * thf);
    const double lr = mag * (double)cosf(thf), li = mag * (double)sinf(thf);
    const double lrm1 = expm1(dt * are) - mag * 2.0 * (double)sh * (double)sh;
    lamv = make_float2((float)lr, (float)li);
    const double mag64 = exp(64.0 * dt * are);
    double th64 = 64.0 * dt * aim * 0.15915494309189535; th64 -= rint(th64); th64 *= 6.283185307179586;
    lam64v = make_float2((float)(mag64 * (double)cosf((float)th64)), (float)(mag64 * (double)sinf((float)th64)));
    const double den = are * are + aim * aim;
    fre = (float)((lrm1 * are + li * aim) / den); fim = (float)((li * are - lrm1 * aim) / den);
}

DEVI void phase0(const P& p) {
    const int gtid = blockIdx.x * 512 + tidx(), gsz = gridDim.x * 512;
    const int gw = gtid >> 6, nw = gsz >> 6, lane = tidx() & 63;
    bf16_t* xb = (bf16_t*)(p.ws + W_XB); float* rs = (float*)(p.ws + W_RS);
    for (int r = gw * 2; r < NROWS_PAD; r += nw * 2) {
        const float* src0 = row_src(p, r); const float* src1 = row_src(p, r + 1);
        f32x4 v[2][4]; float ss0 = 0.f, ss1 = 0.f;
#pragma unroll
        for (int i = 0; i < 4; ++i) {
            v[0][i] = src0 ? *(const f32x4*)(src0 + (i * 64 + lane) * 4) : (f32x4){0.f, 0.f, 0.f, 0.f};
            v[1][i] = src1 ? *(const f32x4*)(src1 + (i * 64 + lane) * 4) : (f32x4){0.f, 0.f, 0.f, 0.f};
        }
#pragma unroll
        for (int i = 0; i < 4; ++i) {
            ss0 += v[0][i][0] * v[0][i][0] + v[0][i][1] * v[0][i][1] + v[0][i][2] * v[0][i][2] + v[0][i][3] * v[0][i][3];
            ss1 += v[1][i][0] * v[1][i][0] + v[1][i][1] * v[1][i][1] + v[1][i][2] * v[1][i][2] + v[1][i][3] * v[1][i][3];
        }
#pragma unroll
        for (int o = 32; o >= 1; o >>= 1) { ss0 += __shfl_xor(ss0, o); ss1 += __shfl_xor(ss1, o); }
        if (lane == 0) { rs[r] = rsqrtf(ss0 * (1.f / 1024.f) + EPS); rs[r + 1] = rsqrtf(ss1 * (1.f / 1024.f) + EPS); }
#pragma unroll
        for (int i = 0; i < 4; ++i) {
            u32x2 w0 = {pk2(v[0][i][0], v[0][i][1]), pk2(v[0][i][2], v[0][i][3])}; *(u32x2*)(xb + (size_t)r * 1024 + (i * 64 + lane) * 4) = w0;
            u32x2 w1 = {pk2(v[1][i][0], v[1][i][1]), pk2(v[1][i][2], v[1][i][3])}; *(u32x2*)(xb + (size_t)(r + 1) * 1024 + (i * 64 + lane) * 4) = w1;
        }
    }
    bf16_t* winT = (bf16_t*)(p.ws + W_WINT);
    for (int i = gtid; i < 2304 * 128; i += gsz) {
        const int n = i % 2304, k8 = i / 2304; float t[8];
        const int f = (n & ~255) + ((n >> 5) & 3) * 64 + ((n >> 7) & 1) * 32 + (n & 31);
#pragma unroll
        for (int j = 0; j < 8; ++j) t[j] = p.w_in[(size_t)(k8 * 8 + j) * 2304 + f] * p.norm_w[k8 * 8 + j];
        u32x4 w = {pk2(t[0], t[1]), pk2(t[2], t[3]), pk2(t[4], t[5]), pk2(t[6], t[7])};
        *(u32x4*)(winT + (size_t)n * 1024 + k8 * 8) = w;
    }
    {
        bf16_t* kF = (bf16_t*)(p.ws + W_KF); bf16_t* vF = (bf16_t*)(p.ws + W_VF);
        for (int i = gtid; i < 2 * 130 * 256; i += gsz) {
            const int piece = i & 255, s = (i >> 8) % 130, kvh = (i >> 8) / 130;
            const int blk = s < 2 ? s * 257 + 256 : 514 + (s - 2) * 5 + 4;
            const u32x4 z = {0u, 0u, 0u, 0u};
            *(u32x4*)(kF + (size_t)(kvh * NBLK + blk) * 2048 + piece * 8) = z;
            *(u32x4*)(vF + (size_t)(kvh * NBLK + blk) * 2048 + piece * 8) = z;
        }
    }
    float2* rope = (float2*)(p.ws + W_ROPE);
    for (int i = gtid; i < LP * 32; i += gsz) {
        const int pos = i >> 5, d = i & 31;
        const double inv = exp2(-(double)d * (13.287712379549449 / 32.0));
        double t = (double)pos * inv * 0.15915494309189535; t -= rint(t);
        const float r = (float)(t * 6.283185307179586);
        rope[i] = make_float2(cosf(r), sinf(r));
    }
}

DEVI void deferred_prep(const P& p, int gtid, int gsz) {
    bf16_t* wgT = (bf16_t*)(p.ws + W_WGLUT);
    for (int i = gtid; i < 512 * 64; i += gsz) {
        const int n = i % 512, k8 = i / 512; float t[8];
#pragma unroll
        for (int j = 0; j < 8; ++j) t[j] = p.w_glu[(size_t)(k8 * 8 + j) * 512 + n];
        u32x4 w = {pk2(t[0], t[1]), pk2(t[2], t[3]), pk2(t[4], t[5]), pk2(t[6], t[7])};
        *(u32x4*)(wgT + (size_t)n * 512 + k8 * 8) = w;
    }
    bf16_t* woT = (bf16_t*)(p.ws + W_WOUTT);
    for (int i = gtid; i < 1024 * 128; i += gsz) {
        const int n = i % 1024, k8 = i / 1024; float t[8];
#pragma unroll
        for (int j = 0; j < 8; ++j) { const int k = k8 * 8 + j; t[j] = p.w_out[(size_t)k * 1024 + n] * (k < 512 ? p.aon_w[k] : p.son_w[k - 512]); }
        u32x4 w = {pk2(t[0], t[1]), pk2(t[2], t[3]), pk2(t[4], t[5]), pk2(t[6], t[7])};
        *(u32x4*)(woT + (size_t)n * 1024 + k8 * 8) = w;
    }
    {
        bf16_t* kF = (bf16_t*)(p.ws + W_KF); bf16_t* vF = (bf16_t*)(p.ws + W_VF);
        for (int i = gtid; i < 2 * 128 * 4 * 4 * 64; i += gsz) {
            const int ln = i & 63, ks = (i >> 6) & 3, kb = (i >> 8) & 3, db = (i >> 10) & 127, kvh = i >> 17;
            const float* kp = p.cache_k + ((size_t)(db * 128 + kb * 32 + (ln & 31)) * 2 + kvh) * 64 + ks * 16 + (ln >> 5) * 8;
            const f32x4 a = *(const f32x4*)kp, c = *(const f32x4*)(kp + 4);
            u32x4 w = {pk2(a[0], a[1]), pk2(a[2], a[3]), pk2(c[0], c[1]), pk2(c[2], c[3])};
            *(u32x4*)(kF + ((size_t)((kvh * NBLK + 514 + db * 5 + kb) * 4 + ks) * 64 + ln) * 8) = w;
            const int db2 = ks >> 1, s2 = ks & 1, h = ln >> 5; float t[8];
#pragma unroll
            for (int j = 0; j < 8; ++j) { const int key = 16 * s2 + 8 * (j >> 2) + 4 * h + (j & 3);
                t[j] = p.cache_v[((size_t)(db * 128 + kb * 32 + key) * 2 + kvh) * 64 + db2 * 32 + (ln & 31)]; }
            u32x4 wv = {pk2(t[0], t[1]), pk2(t[2], t[3]), pk2(t[4], t[5]), pk2(t[6], t[7])};
            *(u32x4*)(vF + ((size_t)(((kvh * NBLK + 514 + db * 5 + kb) * 2 + db2) * 2 + s2) * 64 + ln) * 8) = wv;
        }
    }
    float2* lam = (float2*)(p.ws + W_LAM); float2* lam64 = (float2*)(p.ws + W_LAM64);
    bf16_t* bbarF = (bf16_t*)(p.ws + W_BBARF); bf16_t* cmF = (bf16_t*)(p.ws + W_CMF);
    for (int e = gsz - 1 - gtid; e < 32 * 64 * 16; e += gsz) {
        const int i = e >> 4, h = e & 15, g = i >> 6, n = i & 63;
        float fre, fim; float2 lv, l64v; p0_ssm_f(p, i, fre, fim, lv, l64v);
        if (h == 0) { lam[i] = lv; lam64[i] = l64v; }
        const float Br = p.B_re[(size_t)i * 16 + h], Bi = p.B_im[(size_t)i * 16 + h];
        const float bre = fre * Br - fim * Bi, bim = fre * Bi + fim * Br;
        const int cf0 = (n >= 32 ? 2 : 0), ln = (h >> 3) * 32 + (n & 31), j = h & 7;
        bbarF[((size_t)(g * 4 + cf0) * 64 + ln) * 8 + j] = f2bf(bre);
        bbarF[((size_t)(g * 4 + cf0 + 1) * 64 + ln) * 8 + j] = f2bf(bim);
        const int ho = h;
        const float cre = p.C_re[(size_t)(g * 16 + ho) * 64 + n], cim = p.C_im[(size_t)(g * 16 + ho) * 64 + n];
#pragma unroll
        for (int part = 0; part < 2; ++part) {
            const int kk = 2 * n + part, ks = kk >> 5, q = (kk & 31) >> 3, jj = kk & 7, ln2 = q * 16 + ho;
            cmF[((size_t)(g * 4 + ks) * 64 + ln2) * 8 + jj] = f2bf(part ? -cim : cre);
        }
    }
}

template <bool SAMPLE>
DEVI int attn_blk(int kb, int ia, int b, int q0) {
    if (SAMPLE) return 514 + ia * 5 + kb;
    int kpos0 = q0 - 128 + 32 * kb; kpos0 = kpos0 < 0 ? 0 : kpos0;
    return b * 257 + (kpos0 >> 5);
}
DEVI void attn_load_k(const P& p, int blk, int kvh, int lane, bf16x8 (&kfr)[4]) {
    const bf16_t* kF = (const bf16_t*)(p.ws + W_KF);
#pragma unroll
    for (int ks = 0; ks < 4; ++ks) kfr[ks] = *(const bf16x8*)(kF + ((size_t)((kvh * NBLK + blk) * 4 + ks) * 64 + lane) * 8);
}
DEVI void attn_load_v(const P& p, int blk, int kvh, int lane, bf16x8 (&vfr)[2][2]) {
    const bf16_t* vF = (const bf16_t*)(p.ws + W_VF);
#pragma unroll
    for (int db2 = 0; db2 < 2; ++db2)
#pragma unroll
        for (int s2 = 0; s2 < 2; ++s2) vfr[db2][s2] = *(const bf16x8*)(vF + ((size_t)(((kvh * NBLK + blk) * 2 + db2) * 2 + s2) * 64 + lane) * 8);
}

template <bool SAMPLE>
DEVI void attn_unit(const P& p, int ia, int ib, int ic) {
    const int lane = tidx() & 63, c5 = lane & 31, h = lane >> 5;
    const bf16_t* qb = (const bf16_t*)(p.ws + W_QB);
    int rowq, head, kvh, b = 0, q0 = 0; bool qok;
    if (SAMPLE) { const int db = ia; kvh = ib; head = kvh * 4 + (c5 & 3); rowq = NPR + db * 8 + (c5 >> 2); qok = true; }
    else { b = ia; head = ib; kvh = head >> 2; q0 = ic * 32; rowq = b * LP + q0 + c5; qok = (q0 + c5) < LP; }
    bf16x8 kfr[5][4], vfr[3][2][2];
#pragma unroll
    for (int kb = 0; kb < 5; ++kb) attn_load_k(p, attn_blk<SAMPLE>(kb, ia, b, q0), kvh, lane, kfr[kb]);
    bf16x8 qf[4];
#pragma unroll
    for (int ks = 0; ks < 4; ++ks) qf[ks] = *(const bf16x8*)(qb + (size_t)rowq * 512 + head * 64 + ks * 16 + h * 8);
#pragma unroll
    for (int kb = 0; kb < 3; ++kb) attn_load_v(p, attn_blk<SAMPLE>(kb, ia, b, q0), kvh, lane, vfr[kb]);
    float m = p.sinks[head] * LOG2E, lsum = h == 0 ? 1.f : 0.f;
    f32x16 O[2];
#pragma unroll
    for (int i = 0; i < 16; ++i) { O[0][i] = 0.f; O[1][i] = 0.f; }
    const int tq = SAMPLE ? (c5 >> 2) : c5;
    auto body = [&](int kb, const bf16x8 (&kf)[4], const bf16x8 (&vf)[2][2]) {
        const bool blk_ok = SAMPLE ? true : (q0 - 128 + 32 * kb) >= 0;
        f32x16 S;
#pragma unroll
        for (int i = 0; i < 16; ++i) S[i] = 0.f;
#pragma unroll
        for (int ks = 0; ks < 4; ++ks) S = mfma32(kf[ks], qf[ks], S);
        float mx = -3.0e38f;
#pragma unroll
        for (int i = 0; i < 16; ++i) {
            const int ki = (i & 3) + 8 * (i >> 2) + 4 * h;
            bool valid = blk_ok;
            if (kb == 0) valid = valid && (ki > tq); else if (kb == 4) valid = valid && (ki <= tq);
            S[i] = valid ? S[i] : -3.0e38f;
            mx = fmaxf(mx, S[i]);
        }
        mx = fmaxf(mx, __shfl_xor(mx, 32));
        const float mnew = fmaxf(m, mx), alpha = exp2f(m - mnew); m = mnew;
        float ps = 0.f; float pv[16];
#pragma unroll
        for (int i = 0; i < 16; ++i) { pv[i] = exp2f(S[i] - mnew); ps += pv[i]; }
        lsum = lsum * alpha + ps;
#pragma unroll
        for (int i = 0; i < 16; ++i) { O[0][i] *= alpha; O[1][i] *= alpha; }
        const bf16x8 pf0 = mk8(pk2(pv[0], pv[1]), pk2(pv[2], pv[3]), pk2(pv[4], pv[5]), pk2(pv[6], pv[7]));
        const bf16x8 pf1 = mk8(pk2(pv[8], pv[9]), pk2(pv[10], pv[11]), pk2(pv[12], pv[13]), pk2(pv[14], pv[15]));
#pragma unroll
        for (int db2 = 0; db2 < 2; ++db2) { O[db2] = mfma32(vf[db2][0], pf0, O[db2]); O[db2] = mfma32(vf[db2][1], pf1, O[db2]); }
    };
    body(0, kfr[0], vfr[0]);
    attn_load_v(p, attn_blk<SAMPLE>(3, ia, b, q0), kvh, lane, vfr[0]);
    body(1, kfr[1], vfr[1]);
    attn_load_v(p, attn_blk<SAMPLE>(4, ia, b, q0), kvh, lane, vfr[1]);
    body(2, kfr[2], vfr[2]);
    body(3, kfr[3], vfr[0]);
    body(4, kfr[4], vfr[1]);
    lsum += __shfl_xor(lsum, 32);
    const float inv = 1.f / lsum;
    const bf16_t* ga = (const bf16_t*)(p.ws + W_GA) + (size_t)rowq * 512 + head * 64;
    const int rowq3 = row3_of(rowq);
    bf16_t* ao = (bf16_t*)(p.ws + W_CAT) + (size_t)rowq3 * 1024 + head * 64;
    float ssq = 0.f;
#pragma unroll
    for (int db2 = 0; db2 < 2; ++db2)
#pragma unroll
        for (int a = 0; a < 4; ++a) {
            const int d0 = db2 * 32 + 8 * a + 4 * h;
            const u32x2 gw = qok ? *(const u32x2*)(ga + d0) : (u32x2){0u, 0u};
            const float g0 = bflo(gw[0]), g1 = bfhi(gw[0]), g2 = bflo(gw[1]), g3 = bfhi(gw[1]);
            const float o0 = O[db2][4 * a] * inv * silu_f(g0), o1 = O[db2][4 * a + 1] * inv * silu_f(g1), o2 = O[db2][4 * a + 2] * inv * silu_f(g2), o3 = O[db2][4 * a + 3] * inv * silu_f(g3);
            ssq += o0 * o0 + o1 * o1 + o2 * o2 + o3 * o3;
            if (qok) { u32x2 w = {pk2(o0, o1), pk2(o2, o3)}; *(u32x2*)(ao + d0) = w; }
        }
    ssq += __shfl_xor(ssq, 32);
    if (qok && h == 0) ((float*)(p.ws + W_SSQA))[(size_t)rowq3 * 8 + head] = ssq;
}

template <bool PASS2, bool FULLV = false>
DEVI void ssm_item(const P& p, char* wlds, bool sample, int ia, int g, int c) {
    const int lane = tidx() & 63, c5 = lane & 31, hh = lane >> 5;
    const bf16_t* uG = (const bf16_t*)(p.ws + W_UG) + (size_t)g * NROWS_PAD * 16;
    const float2* lamT = (const float2*)(p.ws + W_LAM) + g * 64; const float2* lam64T = (const float2*)(p.ws + W_LAM64) + g * 64;
    const float2 l0 = lamT[c5], l1 = lamT[32 + c5];
    int rowbase, nvalid, nrb;
    if (sample) { rowbase = NPR + (2 * ia + hh) * 8; nvalid = 8; nrb = 1; }
    else { const int pos0 = c * 128 + 64 * hh; rowbase = ia * LP + pos0; nvalid = LP - pos0; nvalid = nvalid < 0 ? 0 : (nvalid > 64 ? 64 : nvalid); nrb = c == 64 ? 1 : 4; }
    bf16x8 bfr[4];
#pragma unroll
    for (int cf = 0; cf < 4; ++cf) bfr[cf] = *(const bf16x8*)((const bf16_t*)(p.ws + W_BBARF) + ((size_t)(g * 4 + cf) * 64 + lane) * 8);
    const int ar_ = lane & 31, ahalf_ = (ar_ >> 2) & 1, aidx_ = (ar_ & 3) + 4 * (ar_ >> 3);
    u32x4 uall[4]; u32x2 dall[4][2];
    { int rbase_a, nv_a;
      if (sample) { rbase_a = NPR + (2 * ia + ahalf_) * 8; nv_a = 8; } else { const int pos0 = c * 128 + 64 * ahalf_; rbase_a = ia * LP + pos0; nv_a = LP - pos0; nv_a = nv_a < 0 ? 0 : (nv_a > 64 ? 64 : nv_a); }
#pragma unroll
      for (int rb = 0; rb < 4; ++rb) { const int ti = rb * 16 + aidx_; uall[rb] = (u32x4){0u, 0u, 0u, 0u};
          if (rb < nrb && ti < nv_a) uall[rb] = *(const u32x4*)(uG + (size_t)(rbase_a + ti) * 16 + (lane >> 5) * 8); }
      if (PASS2) {
#pragma unroll
          for (int tb = 0; tb < 2; ++tb) { int rb_base, nv_t;
              if (sample) { rb_base = NPR + (2 * ia + tb) * 8; nv_t = 8; } else { const int pos0 = c * 128 + 64 * tb; rb_base = ia * LP + pos0; nv_t = LP - pos0; nv_t = nv_t < 0 ? 0 : (nv_t > 64 ? 64 : nv_t); }
#pragma unroll
              for (int rb = 0; rb < 4; ++rb) { const int ti = rb * 16 + (lane & 15); dall[rb][tb] = (u32x2){0u, 0u};
                  if (rb < nrb && ti < nv_t) dall[rb][tb] = *(const u32x2*)(uG + (size_t)(rb_base + ti) * 16 + (lane >> 4) * 4); } }
      }
    }
    float x0r = 0.f, x0i = 0.f, x1r = 0.f, x1i = 0.f;
    if (PASS2) {
        if (sample) { const size_t o = ((size_t)(2 * ia + hh) * 32 + g) * 64; x0r = p.st_re[o + c5]; x0i = p.st_im[o + c5]; x1r = p.st_re[o + 32 + c5]; x1i = p.st_im[o + 32 + c5]; }
        else {
            int sc = 2 * c + hh; sc = sc > 128 ? 128 : sc;
            const float2* cy = (const float2*)(p.ws + W_CARRY) + ((size_t)(ia * 32 + g) * 129 + sc) * 64;
            const float2 c0 = cy[c5], c1 = cy[32 + c5];
            x0r = c0.x; x0i = c0.y; x1r = c1.x; x1i = c1.y;
        }
    }
    bf16x8 cfr[4];
    float dsk[4];
    if (PASS2) {
#pragma unroll
        for (int ks = 0; ks < 4; ++ks) cfr[ks] = *(const bf16x8*)((const bf16_t*)(p.ws + W_CMF) + ((size_t)(g * 4 + ks) * 64 + lane) * 8);
        const f32x4 d4 = *(const f32x4*)(p.Dk + g * 16 + (lane >> 4) * 4);
        dsk[0] = d4[0]; dsk[1] = d4[1]; dsk[2] = d4[2]; dsk[3] = d4[3];
    }
#pragma unroll
    for (int rb = 0; rb < 4; ++rb) {
        if (rb >= nrb) break;
        {
          const bf16x8 af = __builtin_bit_cast(bf16x8, uall[rb]);
          f32x16 bu[4];
#pragma unroll
          for (int cf = 0; cf < 4; ++cf) {
#pragma unroll
              for (int i = 0; i < 16; ++i) bu[cf][i] = 0.f;
              bu[cf] = mfma32(af, bfr[cf], bu[cf]);
          }
          const int nv_here = nvalid - rb * 16;
          unsigned* xw = (unsigned*)wlds;
#pragma unroll
          for (int i = 0; i < 16; ++i) {
              const float a = l0.x * x0r - l0.y * x0i + bu[0][i], bq = l0.x * x0i + l0.y * x0r + bu[1][i];
              const float cc = l1.x * x1r - l1.y * x1i + bu[2][i], dq = l1.x * x1i + l1.y * x1r + bu[3][i];
              if (PASS2 && !FULLV) { const bool v = i < nv_here; x0r = v ? a : x0r; x0i = v ? bq : x0i; x1r = v ? cc : x1r; x1i = v ? dq : x1i; }
              else { x0r = a; x0i = bq; x1r = cc; x1i = dq; }
              if (PASS2) { xw[(hh * 16 + i) * 68 + c5] = pk2(x0r, x0i); xw[(hh * 16 + i) * 68 + 32 + c5] = pk2(x1r, x1i); }
          }
        }
        if (PASS2) {
#pragma unroll
            for (int tb = 0; tb < 2; ++tb) {
                f32x4 y = {0.f, 0.f, 0.f, 0.f};
#pragma unroll
                for (int ks = 0; ks < 4; ++ks) {
                    const bf16x8 xf = *(const bf16x8*)(wlds + (tb * 16 + (lane & 15)) * 272 + ks * 64 + (lane >> 4) * 16);
                    y = mfma16(cfr[ks], xf, y);
                }
                int rb_base, nv_t;
                if (sample) { rb_base = NPR + (2 * ia + tb) * 8; nv_t = 8; } else { const int pos0 = c * 128 + 64 * tb; rb_base = ia * LP + pos0; nv_t = LP - pos0; nv_t = nv_t < 0 ? 0 : (nv_t > 64 ? 64 : nv_t); }
                const int ti = rb * 16 + (lane & 15);
                if (ti < nv_t) {
                    const int row = rb_base + ti;
                    const u32x2 uw = dall[rb][tb];
                    const float y0 = y[0] + dsk[0] * bflo(uw[0]), y1 = y[1] + dsk[1] * bfhi(uw[0]), y2 = y[2] + dsk[2] * bflo(uw[1]), y3 = y[3] + dsk[3] * bfhi(uw[1]);
                    u32x2 w = {pk2(gelu_tanh(y0), gelu_tanh(y1)), pk2(gelu_tanh(y2), gelu_tanh(y3))};
                    *(u32x2*)(gb_base(p.ws, sample) + (size_t)row3_of(row) * 512 + g * 16 + (lane >> 4) * 4) = w;
                }
            }
        }
    }
    if (!PASS2) {
        float2* ends = (float2*)(p.ws + W_ENDS) + (size_t)(ia * 32 + g) * 128 * 64 + (size_t)(2 * c + hh) * 64;
        ends[c5] = make_float2(x0r, x0i); ends[32 + c5] = make_float2(x1r, x1i);
    } else {
        if (sample) { const size_t o = ((size_t)(2 * ia + hh) * 32 + g) * 64;
            p.out[O_SRS + o + c5] = x0r; p.out[O_SIS + o + c5] = x0i; p.out[O_SRS + o + 32 + c5] = x1r; p.out[O_SIS + o + 32 + c5] = x1i; }
        else if (c == 64 && hh == 0) { const size_t o = ((size_t)ia * 32 + g) * 64;
            p.out[O_SRP + o + c5] = x0r; p.out[O_SIP + o + c5] = x0i; p.out[O_SRP + o + 32 + c5] = x1r; p.out[O_SIP + o + 32 + c5] = x1i; }
    }
}

DEVI void phase2a(const P& p, char* lds) {
    const int tid = tidx(), wid = tid >> 6, lane = tid & 63;
    if (blockIdx.x < 64) {
        const int bg = blockIdx.x, g = bg & 31, b = bg >> 5;
#pragma unroll 1
        for (int k = 0; k < 8; ++k) ssm_item<false>(p, lds + wid * 8704, false, b, g, wid * 8 + k);
        asm volatile("s_waitcnt vmcnt(0)" ::: "memory");
        __syncthreads();
        const float2 L = ((const float2*)(p.ws + W_LAM64))[g * 64 + lane];
        const float2* ends = (const float2*)(p.ws + W_ENDS) + (size_t)bg * 128 * 64 + (size_t)(16 * wid) * 64 + lane;
        float2 e[16];
#pragma unroll
        for (int s = 0; s < 16; ++s) e[s] = ends[s * 64];
        float xr = 0.f, xi = 0.f;
#pragma unroll
        for (int s = 0; s < 16; ++s) { const float a = L.x * xr - L.y * xi + e[s].x, bq = L.x * xi + L.y * xr + e[s].y; xr = a; xi = bq; }
        float pr = L.x, pi = L.y;
#pragma unroll
        for (int k = 0; k < 4; ++k) { const float a = pr * pr - pi * pi, bq = 2.f * pr * pi; pr = a; pi = bq; }
        float2* seg = (float2*)lds;
        seg[wid * 64 + lane] = make_float2(xr, xi);
        __syncthreads();
        float cr = 0.f, ci = 0.f;
        for (int i = 0; i < wid; ++i) { const float2 q = seg[i * 64 + lane]; const float a = pr * cr - pi * ci + q.x, bq = pr * ci + pi * cr + q.y; cr = a; ci = bq; }
        float2* cy = (float2*)(p.ws + W_CARRY) + (size_t)bg * 129 * 64 + (size_t)(16 * wid) * 64 + lane;
        xr = cr; xi = ci;
#pragma unroll
        for (int s = 0; s < 16; ++s) { cy[s * 64] = make_float2(xr, xi); const float a = L.x * xr - L.y * xi + e[s].x, bq = L.x * xi + L.y * xr + e[s].y; xr = a; xi = bq; }
        if (wid == 7) cy[16 * 64] = make_float2(xr, xi);
        __syncthreads();
    } else {
        const int vb0 = (int)blockIdx.x - 64;
        const int w = ((vb0 & 7) * 24 + (vb0 >> 3)) * 8 + wid;
        for (int u = w; u < 4096; u += 1536) { const int head = u & 7, r = u >> 3, qblk = r & 255, b = r >> 8; attn_unit<false>(p, b, head, qblk); }
        { const int e = w - 1024; if (e >= 0 && e < 16) attn_unit<false>(p, e >> 3, e & 7, 256); }
        { const int s = w - 1024 - 16; if (s >= 0 && s < 256) attn_unit<true>(p, s >> 1, s & 1, 0); }
        if (w < 1296) ssm_item<true>(p, lds + wid * 8704, true, w >> 5, w & 31, 0);
        else for (int u = w; u < 2048; u += 240) ssm_item<true>(p, lds + wid * 8704, true, u >> 5, u & 31, 0);
    }
}
DEVI void phase2b(const P& p, char* lds) {
    const int wid = tidx() >> 6;
    for (int it = blockIdx.x * 8 + wid; it < 4096; it += 232 * 8) { const int c = it & 63, g = (it >> 6) & 31, b = it >> 11; ssm_item<true, true>(p, lds + wid * 8704, false, b, g, c); }
    for (int it = (231 - (int)blockIdx.x) * 8 + wid; it < 64; it += 232 * 8) ssm_item<true, false>(p, lds + wid * 8704, false, it >> 5, it & 31, 64);
}

namespace pg8 {
#define PG8_LAS __attribute__((address_space(3)))
constexpr int BM = 256, BK = 64, HALF = 128, HTB = HALF * BK * 2  , STAGE_BYTES = 8 * HTB, NXCD = 8, WGM = 8;
__host__ __device__ __forceinline__ int lds_byte(int r, int c) { const int st = (r >> 4) * 2 + (c >> 5), rr = r & 15, cc = c & 31, ob = rr * 64 + cc * 2; return st * 1024 + (ob ^ (((ob >> 9) & 1) << 5)); }
__host__ __device__ __forceinline__ void stage_rc(int b, int& R, int& C) { const int st = b / 1024, sb = b % 1024, swz = sb ^ (((sb >> 9) & 1) << 5); R = (st >> 1) * 16 + swz / 64; C = (st & 1) * 32 + (swz % 64) / 2; }
__host__ __device__ __forceinline__ int perm32(int rho) { const int n = rho >> 4, i = rho & 15; return 8 * (i >> 2) + 4 * n + (i & 3); }
struct Unit { int pm, pn; };
struct Gemm { const bf16_t* A; const bf16_t* Bt; int lda, ldb, K; };
struct StaticOrder {
    int nM, nN, nwg, G, c;
    __host__ __device__ void init(int M, int N, int G_, int c_) { nM = M / BM; nN = N / BM; nwg = nM * nN; G = G_; c = c_; }
    __host__ __device__ bool next(int i, Unit& u) const {
        const long L = (long)i * G + c; if (L >= nwg) return false;
        int wgid = (int)L; { const int q = nwg / NXCD, r = nwg % NXCD, xcd = wgid % NXCD, off = wgid / NXCD; wgid = (xcd < r ? xcd * (q + 1) : r * (q + 1) + (xcd - r) * q) + off; }
        const int nig = WGM * nN, gid = wgid / nig, fm = gid * WGM, gsz = (nM - fm) < WGM ? (nM - fm) : WGM;
        u.pm = fm + ((wgid % nig) % gsz); u.pn = (wgid % nig) / gsz; return true;
    }
};
template <class Epi, class Sched>
__device__ __forceinline__ void gemm_phase(PG8_LAS unsigned char* lds, const Gemm g, const Sched& S, const Epi& E) {
    const int tid = tidx(), wid = __builtin_amdgcn_readfirstlane(tid >> 6), lane = tid & 63, wr = wid >> 2, wc = wid & 3, fr = lane & 15, fq = lane >> 4;
    const int K = g.K, nt = K / BK;
    unsigned voffA[2], voffB[2];
#pragma unroll
    for (int i = 0; i < 2; ++i) { int R, C; stage_rc(tid * 16 + i * 8192, R, C); const int Rb = (R & ~31) + perm32(R & 31); voffA[i] = (unsigned)(R * g.lda + C) * 2u; voffB[i] = (unsigned)(Rb * g.ldb + C) * 2u; }
    const size_t kstep = (size_t)(BK * 2);
    const size_t hstepA = (size_t)HALF * g.lda * 2, hstepB = (size_t)HALF * g.ldb * 2;
    const size_t tstepA = 2 * hstepA, tstepB = 2 * hstepB;
    const unsigned ldsw = (unsigned)wid * 1024u;
    const int aoff = lds_byte(wr * 64 + fr, fq * 8), boff = lds_byte(wc * 32 + fr, fq * 8);
#define PG8_SA(b, h) (((b) * 2 + (h)) * HTB)
#define PG8_SB(b, h) ((4 + (b) * 2 + (h)) * HTB)
#define PG8_STAGE(bufoff, gbase, voff) do { _Pragma("unroll") for (int _i = 0; _i < 2; ++_i) \
        __builtin_amdgcn_global_load_lds((const unsigned*)((const char*)(gbase) + (voff)[_i]), (PG8_LAS unsigned*)(lds + (bufoff) + ldsw + _i * 8192), 16, 0, 0); } while (0)
#define PG8_LDA(dst, b, h) do { _Pragma("unroll") for (int m = 0; m < 4; ++m) _Pragma("unroll") for (int k = 0; k < 2; ++k) dst[m][k] = *(const PG8_LAS bf16x8*)(lds + PG8_SA(b, h) + aoff + m * 2048 + k * 1024); } while (0)
#define PG8_LDB(dst, b, h) do { _Pragma("unroll") for (int n = 0; n < 2; ++n) _Pragma("unroll") for (int k = 0; k < 2; ++k) dst[n][k] = *(const PG8_LAS bf16x8*)(lds + PG8_SB(b, h) + boff + n * 2048 + k * 1024); } while (0)
#define PG8_MMA(ai, bj, At, Bt) do { __builtin_amdgcn_s_setprio(1); _Pragma("unroll") for (int m = 0; m < 4; ++m) _Pragma("unroll") for (int n = 0; n < 2; ++n) _Pragma("unroll") for (int k = 0; k < 2; ++k) \
        acc[ai][bj][m][n] = __builtin_amdgcn_mfma_f32_16x16x32_bf16(Bt[n][k], At[m][k], acc[ai][bj][m][n], 0, 0, 0); __builtin_amdgcn_s_setprio(0); } while (0)
#define PG8_WAIT_V(n) asm volatile("s_waitcnt vmcnt(" #n ")" ::: "memory")
#define PG8_WAIT_L(n) asm volatile("s_waitcnt lgkmcnt(" #n ")" ::: "memory")
#define PG8_BAR __builtin_amdgcn_s_barrier()
#define PG8_SCHED __builtin_amdgcn_sched_barrier(0)
    Unit cur, nxt; int ui = 0;
    if (!S.next(0, cur)) return;
    f32x4 acc[2][2][4][2];
#pragma unroll
    for (int a = 0; a < 2; ++a)
#pragma unroll
        for (int b = 0; b < 2; ++b)
#pragma unroll
            for (int m = 0; m < 4; ++m)
#pragma unroll
                for (int n = 0; n < 2; ++n) acc[a][b][m][n] = (f32x4){0.f, 0.f, 0.f, 0.f};
    bf16x8 At[4][2], B0[2][2], B1[2][2];
    const char* cA = (const char*)g.A + (size_t)cur.pm * tstepA; const char* cB = (const char*)g.Bt + (size_t)cur.pn * tstepB;
    E.begin(cur, 0, tid, lds);
    asm volatile("s_waitcnt vmcnt(0) lgkmcnt(0)" ::: "memory");
    PG8_BAR;
    PG8_STAGE(PG8_SB(0, 0), cB, voffB); PG8_STAGE(PG8_SB(0, 1), cB + hstepB, voffB); PG8_STAGE(PG8_SA(0, 0), cA, voffA); PG8_STAGE(PG8_SA(0, 1), cA + hstepA, voffA);
    if (wr == 1) PG8_BAR;
    PG8_WAIT_V(2); PG8_BAR;
    PG8_STAGE(PG8_SB(1, 0), cB + kstep, voffB); PG8_STAGE(PG8_SA(1, 0), cA + kstep, voffA); PG8_STAGE(PG8_SB(1, 1), cB + hstepB + kstep, voffB);
    PG8_WAIT_V(6); PG8_BAR;
    for (;;) {
        const bool has_next = S.next(ui + 1, nxt);
        const char* nA = has_next ? (const char*)g.A + (size_t)nxt.pm * tstepA : cA; const char* nB = has_next ? (const char*)g.Bt + (size_t)nxt.pn * tstepB : cB;
        for (int t = 0; t < nt; t += 2) {
            const bool last = (t == nt - 2);
            const char* a1 = cA + (size_t)(t + 1) * kstep;
            const char* a2 = last ? nA : cA + (size_t)(t + 2) * kstep; const char* b2 = last ? nB : cB + (size_t)(t + 2) * kstep;
            const char* a3 = a2 + kstep; const char* b3 = b2 + kstep;
            if constexpr (Epi::HAS_MID) { if (t == nt / 2) E.mid(acc, wr, fr, ui, lds); }
            PG8_LDB(B0, 0, 0); PG8_LDB(B1, 0, 1); PG8_SCHED; PG8_LDA(At, 0, 0); PG8_STAGE(PG8_SA(1, 1), a1 + hstepA, voffA);
            PG8_WAIT_V(8); PG8_WAIT_L(0); PG8_BAR; PG8_MMA(0, 0, At, B0); PG8_MMA(0, 1, At, B1); PG8_BAR; PG8_SCHED;
            PG8_LDA(At, 0, 1); PG8_STAGE(PG8_SB(0, 0), b2, voffB); PG8_STAGE(PG8_SB(0, 1), b2 + hstepB, voffB); PG8_STAGE(PG8_SA(0, 0), a2, voffA);
            PG8_WAIT_V(8); PG8_WAIT_L(0); PG8_BAR; PG8_MMA(1, 0, At, B0); PG8_MMA(1, 1, At, B1); PG8_BAR; PG8_SCHED;
            PG8_LDB(B0, 1, 0); PG8_LDB(B1, 1, 1); PG8_SCHED; PG8_LDA(At, 1, 0); PG8_STAGE(PG8_SA(0, 1), a2 + hstepA, voffA);
            PG8_WAIT_V(8); PG8_WAIT_L(0); PG8_BAR; PG8_MMA(0, 0, At, B0); PG8_MMA(0, 1, At, B1); PG8_BAR; PG8_SCHED;
            PG8_LDA(At, 1, 1); PG8_STAGE(PG8_SB(1, 0), b3, voffB); PG8_STAGE(PG8_SB(1, 1), b3 + hstepB, voffB); PG8_STAGE(PG8_SA(1, 0), a3, voffA);
            PG8_WAIT_V(8); PG8_WAIT_L(0); PG8_BAR; PG8_MMA(1, 0, At, B0); PG8_MMA(1, 1, At, B1); PG8_BAR; PG8_SCHED;
        }
        if (wr == 0) PG8_BAR;
        E(acc, cur, wr, wc, fr, fq, ui, lds);
        if (!has_next) break;
#pragma unroll
        for (int a = 0; a < 2; ++a)
#pragma unroll
            for (int b = 0; b < 2; ++b)
#pragma unroll
                for (int m = 0; m < 4; ++m)
#pragma unroll
                    for (int n = 0; n < 2; ++n) acc[a][b][m][n] = (f32x4){0.f, 0.f, 0.f, 0.f};
        cur = nxt; cA = nA; cB = nB; ++ui;
        E.begin(cur, ui, tid, lds);
        if (wr == 1) PG8_BAR;
    }
    PG8_WAIT_V(0);
    PG8_BAR;
#undef PG8_SA
#undef PG8_SB
#undef PG8_STAGE
#undef PG8_LDA
#undef PG8_LDB
#undef PG8_MMA
#undef PG8_WAIT_V
#undef PG8_WAIT_L
#undef PG8_BAR
#undef PG8_SCHED
}
}

typedef const f32x4 (&AccRef)[2][2][4][2];

struct EpiP1 {
    static constexpr bool HAS_MID = false;
    P p;
    DEVI void begin(const pg8::Unit&, int, int, PG8_LAS unsigned char*) const {}
    DEVI void mid(f32x4 (&)[2][2][4][2], int, int, int, PG8_LAS unsigned char*) const {}
    DEVI void operator()(AccRef acc, const pg8::Unit& u, int wr, int wc, int fr, int fq, int, PG8_LAS unsigned char*) const {
        const float* rs = (const float*)(p.ws + W_RS);
        const int pn = u.pn;
        const int kind = pn < 2 ? 0 : (pn == 2 ? (wc < 2 ? 1 : 2) : (pn < 5 ? 3 : (pn < 7 ? 4 : 5)));
        if (kind <= 1) {
            const float* nw = kind == 0 ? p.q_norm_w : p.k_norm_w;
            f32x4 w4[2][2];
#pragma unroll
            for (int bj = 0; bj < 2; ++bj)
#pragma unroll
                for (int n = 0; n < 2; ++n) w4[bj][n] = *(const f32x4*)(nw + 32 * bj + 8 * fq + 4 * n);
            const float2* rope = (const float2*)(p.ws + W_ROPE);
#pragma unroll
            for (int ai = 0; ai < 2; ++ai)
#pragma unroll
                for (int m = 0; m < 4; ++m) {
                    const int row = u.pm * 256 + ai * 128 + wr * 64 + m * 16 + fr;
                    const float rsv = rs[row];
                    const bool isp = row < NPR; const int b = row >= LP ? 1 : 0;
                    const int pos = isp ? row - b * LP : 8192 + ((row - NPR) & 7);
                    float v[2][2][4]; float ss = 0.f;
#pragma unroll
                    for (int bj = 0; bj < 2; ++bj)
#pragma unroll
                        for (int n = 0; n < 2; ++n)
#pragma unroll
                            for (int j = 0; j < 4; ++j) { v[bj][n][j] = acc[ai][bj][m][n][j] * rsv; ss += v[bj][n][j] * v[bj][n][j]; }
                    ss += __shfl_xor(ss, 16); ss += __shfl_xor(ss, 32);
                    const float rinv = rsqrtf(ss * (1.f / 64.f) + EPS);
                    const int rpos = pos < LP ? pos : LP - 1;
#pragma unroll
                    for (int n = 0; n < 2; ++n) {
                        const f32x4 cs0 = *(const f32x4*)(rope + (size_t)rpos * 32 + 8 * fq + 4 * n);
                        const f32x4 cs1 = *(const f32x4*)(rope + (size_t)rpos * 32 + 8 * fq + 4 * n + 2);
                        const float c[4] = {cs0[0], cs0[2], cs1[0], cs1[2]}, s[4] = {cs0[1], cs0[3], cs1[1], cs1[3]};
#pragma unroll
                        for (int j = 0; j < 4; ++j) { const float x1 = v[0][n][j] * rinv * w4[0][n][j], x2 = v[1][n][j] * rinv * w4[1][n][j];
                            v[0][n][j] = x1 * c[j] - x2 * s[j]; v[1][n][j] = x2 * c[j] + x1 * s[j]; }
                    }
                    if (kind == 0) {
                        if (row < NROWS) { bf16_t* qb = (bf16_t*)(p.ws + W_QB) + (size_t)row * 512 + (pn * 4 + wc) * 64 + 8 * fq;
#pragma unroll
                            for (int bj = 0; bj < 2; ++bj) { u32x4 w = {pk2(v[bj][0][0] * QSCALE, v[bj][0][1] * QSCALE), pk2(v[bj][0][2] * QSCALE, v[bj][0][3] * QSCALE), pk2(v[bj][1][0] * QSCALE, v[bj][1][1] * QSCALE), pk2(v[bj][1][2] * QSCALE, v[bj][1][3] * QSCALE)};
                                *(u32x4*)(qb + 32 * bj) = w; } }
                    } else {
                        const int kvh = wc;
                        if (row < NROWS) {
                            const int blk = isp ? b * 257 + (pos >> 5) : 514 + ((row - NPR) >> 3) * 5 + 4, key = isp ? (pos & 31) : ((row - NPR) & 7);
                            bf16_t* kF = (bf16_t*)(p.ws + W_KF);
#pragma unroll
                            for (int bj = 0; bj < 2; ++bj) { u32x4 w = {pk2(v[bj][0][0], v[bj][0][1]), pk2(v[bj][0][2], v[bj][0][3]), pk2(v[bj][1][0], v[bj][1][1]), pk2(v[bj][1][2], v[bj][1][3])};
                                *(u32x4*)(kF + ((size_t)((kvh * NBLK + blk) * 4 + 2 * bj + (fq >> 1)) * 64 + (fq & 1) * 32 + key) * 8) = w; }
                        }
                        if (isp) {
                            if (pos >= LP - 128) { float* o = p.out + O_KWP + ((size_t)(b * 128 + pos - (LP - 128)) * 2 + kvh) * 64 + 8 * fq;
#pragma unroll
                                for (int bj = 0; bj < 2; ++bj)
#pragma unroll
                                    for (int n = 0; n < 2; ++n) *(f32x4*)(o + 32 * bj + 4 * n) = (f32x4){v[bj][n][0], v[bj][n][1], v[bj][n][2], v[bj][n][3]}; }
                        } else if (row < NROWS) { float* o = p.out + O_KNS + ((size_t)(row - NPR) * 2 + kvh) * 64 + 8 * fq;
#pragma unroll
                            for (int bj = 0; bj < 2; ++bj)
#pragma unroll
                                for (int n = 0; n < 2; ++n) *(f32x4*)(o + 32 * bj + 4 * n) = (f32x4){v[bj][n][0], v[bj][n][1], v[bj][n][2], v[bj][n][3]}; }
                    }
                    asm volatile("" ::: "memory");
                }
        } else if (kind == 2) {
            const int kvh = wc - 2;
#pragma unroll
            for (int ai = 0; ai < 2; ++ai)
#pragma unroll
                for (int m = 0; m < 4; ++m) {
                    const int row = u.pm * 256 + ai * 128 + wr * 64 + m * 16 + fr;
                    const float rsv = rs[row];
                    const bool isp = row < NPR; const int b = row >= LP ? 1 : 0;
                    const int pos = isp ? row - b * LP : 0;
                    if (row < NROWS) {
                        const int blk = isp ? b * 257 + (pos >> 5) : 514 + ((row - NPR) >> 3) * 5 + 4, kk = isp ? (pos & 31) : ((row - NPR) & 7), s2 = kk >> 4, r16 = kk & 15, jj = (r16 >> 3) * 4 + (r16 & 3), hh = (r16 >> 2) & 1;
                        bf16_t* vF = (bf16_t*)(p.ws + W_VF);
#pragma unroll
                        for (int bj = 0; bj < 2; ++bj)
#pragma unroll
                            for (int n = 0; n < 2; ++n)
#pragma unroll
                                for (int j = 0; j < 4; ++j)
                                    vF[((size_t)(((kvh * NBLK + blk) * 2 + bj) * 2 + s2) * 64 + hh * 32 + (8 * fq + 4 * n + j)) * 8 + jj] = f2bf(acc[ai][bj][m][n][j] * rsv);
                    }
                    if (isp) {
                        if (pos >= LP - 128) { float* o = p.out + O_VWP + ((size_t)(b * 128 + pos - (LP - 128)) * 2 + kvh) * 64 + 8 * fq;
#pragma unroll
                            for (int bj = 0; bj < 2; ++bj)
#pragma unroll
                                for (int n = 0; n < 2; ++n) *(f32x4*)(o + 32 * bj + 4 * n) = acc[ai][bj][m][n] * rsv; }
                    } else if (row < NROWS) { float* o = p.out + O_VNS + ((size_t)(row - NPR) * 2 + kvh) * 64 + 8 * fq;
#pragma unroll
                        for (int bj = 0; bj < 2; ++bj)
#pragma unroll
                            for (int n = 0; n < 2; ++n) *(f32x4*)(o + 32 * bj + 4 * n) = acc[ai][bj][m][n] * rsv; }
                    asm volatile("" ::: "memory");
                }
        } else if (kind == 4) {
            bf16_t* uG = (bf16_t*)(p.ws + W_UG);
#pragma unroll
            for (int ai = 0; ai < 2; ++ai)
#pragma unroll
                for (int m = 0; m < 4; ++m) {
                    const int row = u.pm * 256 + ai * 128 + wr * 64 + m * 16 + fr;
                    const float rsv = rs[row];
                    if (row < NROWS) {
#pragma unroll
                        for (int bj = 0; bj < 2; ++bj) { const int g = (pn - 5) * 16 + 4 * wc + 2 * bj + (fq >> 1); const f32x4 t0 = acc[ai][bj][m][0] * rsv, t1 = acc[ai][bj][m][1] * rsv;
                            u32x4 w = {pk2(t0[0], t0[1]), pk2(t0[2], t0[3]), pk2(t1[0], t1[1]), pk2(t1[2], t1[3])}; *(u32x4*)(uG + ((size_t)g * NROWS_PAD + row) * 16 + 8 * (fq & 1)) = w; }
                    }
                }
        } else {
            bf16_t* dst0 = (bf16_t*)(p.ws + (kind == 3 ? W_GA : W_GS)) + (kind == 3 ? pn - 3 : pn - 7) * 256 + 64 * wc + 8 * fq;
#pragma unroll
            for (int ai = 0; ai < 2; ++ai)
#pragma unroll
                for (int m = 0; m < 4; ++m) {
                    const int row = u.pm * 256 + ai * 128 + wr * 64 + m * 16 + fr;
                    const float rsv = rs[row];
                    if (row < NROWS) {
                        const int rowd = kind == 3 ? row : row3_of(row);
#pragma unroll
                        for (int bj = 0; bj < 2; ++bj) { const f32x4 t0 = acc[ai][bj][m][0] * rsv, t1 = acc[ai][bj][m][1] * rsv;
                            u32x4 w = {pk2(t0[0], t0[1]), pk2(t0[2], t0[3]), pk2(t1[0], t1[1]), pk2(t1[2], t1[3])}; *(u32x4*)(dst0 + (size_t)rowd * 512 + 32 * bj) = w; }
                    }
                }
        }
    }
};

struct EpiGlu {
    static constexpr bool HAS_MID = false;
    P p;
    DEVI void begin(const pg8::Unit&, int, int, PG8_LAS unsigned char*) const {}
    DEVI void mid(f32x4 (&)[2][2][4][2], int, int, int, PG8_LAS unsigned char*) const {}
    DEVI void operator()(AccRef acc, const pg8::Unit& u, int wr, int wc, int fr, int fq, int, PG8_LAS unsigned char*) const {
        const bf16_t* gB = gb_base(p.ws, u.pm >= 64); const bf16_t* gs = (const bf16_t*)(p.ws + W_GS);
        bf16_t* cat = (bf16_t*)(p.ws + W_CAT); float* ssqs = (float*)(p.ws + W_SSQS);
        const int f0 = u.pn * 256 + 32 * wc + 8 * fq;
        f32x4 bg[2][2];
#pragma unroll
        for (int bj = 0; bj < 2; ++bj)
#pragma unroll
            for (int n = 0; n < 2; ++n) bg[bj][n] = *(const f32x4*)(p.b_glu + f0 + 128 * bj + 4 * n);
#pragma unroll
        for (int ai = 0; ai < 2; ++ai)
#pragma unroll
            for (int m = 0; m < 4; ++m) {
                const int row = u.pm * 256 + ai * 128 + wr * 64 + m * 16 + fr;
                float ssq = 0.f;
#pragma unroll
                for (int bj = 0; bj < 2; ++bj) {
                    const int f = f0 + 128 * bj;
                    const u32x4 gw = *(const u32x4*)(gB + (size_t)row * 512 + f), sw = *(const u32x4*)(gs + (size_t)row * 512 + f);
                    float s[8];
#pragma unroll
                    for (int n = 0; n < 2; ++n)
#pragma unroll
                        for (int j = 0; j < 4; ++j) { const unsigned gwd = gw[2 * n + (j >> 1)], swd = sw[2 * n + (j >> 1)];
                            const float gl = (j & 1) ? bfhi(gwd) : bflo(gwd), gv = (j & 1) ? bfhi(swd) : bflo(swd);
                            s[4 * n + j] = gl * sigmoid_f(acc[ai][bj][m][n][j] + bg[bj][n][j]) * silu_f(gv); ssq += s[4 * n + j] * s[4 * n + j]; }
                    { u32x4 w = {pk2(s[0], s[1]), pk2(s[2], s[3]), pk2(s[4], s[5]), pk2(s[6], s[7])}; *(u32x4*)(cat + (size_t)row * 1024 + 512 + f) = w; }
                }
                ssq += __shfl_xor(ssq, 16); ssq += __shfl_xor(ssq, 32);
                if (fq == 0) ssqs[(size_t)row * 8 + u.pn * 4 + wc] = ssq;
                asm volatile("" ::: "memory");
            }
    }
};

constexpr int LDS_TAB = 131072;
struct EpiOut {
    static constexpr bool HAS_MID = true;
    P p;
    DEVI void begin(const pg8::Unit& u, int ui, int tid, PG8_LAS unsigned char* lds) const {
        if (tid < 256) {
            const int row = u.pm * 256 + tid;
            float ra = 1.f, rsv = 1.f;
            {
                const float* ssqa = (const float*)(p.ws + W_SSQA) + (size_t)row * 8; const float* ssqs = (const float*)(p.ws + W_SSQS) + (size_t)row * 8;
                const f32x4 a0 = *(const f32x4*)(ssqa), a1 = *(const f32x4*)(ssqa + 4), s0 = *(const f32x4*)(ssqs), s1 = *(const f32x4*)(ssqs + 4);
                ra = rsqrtf(((a0[0] + a0[1]) + (a0[2] + a0[3]) + (a1[0] + a1[1]) + (a1[2] + a1[3])) * (1.f / 512.f) + EPS);
                rsv = rsqrtf(((s0[0] + s0[1]) + (s0[2] + s0[3]) + (s1[0] + s1[1]) + (s1[2] + s1[3])) * (1.f / 512.f) + EPS);
            }
            ((PG8_LAS f32x2*)(lds + LDS_TAB))[(ui & 1) * 256 + tid] = (f32x2){ra / rsv, rsv};
        }
    }
    DEVI void mid(f32x4 (&acc)[2][2][4][2], int wr, int fr, int ui, PG8_LAS unsigned char* lds) const {
#pragma unroll
        for (int ai = 0; ai < 2; ++ai)
#pragma unroll
            for (int m = 0; m < 4; ++m) {
                const float sc = ((const PG8_LAS f32x2*)(lds + LDS_TAB))[(ui & 1) * 256 + ai * 128 + wr * 64 + m * 16 + fr].x;
#pragma unroll
                for (int bj = 0; bj < 2; ++bj)
#pragma unroll
                    for (int n = 0; n < 2; ++n) acc[ai][bj][m][n] *= sc;
            }
    }
    DEVI void operator()(AccRef acc, const pg8::Unit& u, int wr, int wc, int fr, int fq, int ui, PG8_LAS unsigned char* lds) const {
#pragma unroll
        for (int ai = 0; ai < 2; ++ai) {
            f32x4 xv[4][2][2]; size_t off[4]; float rsv[4];
#pragma unroll
            for (int m = 0; m < 4; ++m) {
                const int rl = ai * 128 + wr * 64 + m * 16 + fr, row = u.pm * 256 + rl;
                rsv[m] = ((const PG8_LAS f32x2*)(lds + LDS_TAB))[(ui & 1) * 256 + rl].y;
                const float* xr;
                if (row < 16384) { off[m] = (size_t)row * 1024 + O_YP; xr = p.x_prompt + (size_t)row * 1024; }
                else { off[m] = (size_t)(row - 16384) * 1024 + O_YS; xr = p.x_sample + (size_t)(row - 16384) * 1024; }
#pragma unroll
                for (int bj = 0; bj < 2; ++bj)
#pragma unroll
                    for (int n = 0; n < 2; ++n) xv[m][bj][n] = *(const f32x4*)(xr + u.pn * 256 + 128 * bj + 32 * wc + 8 * fq + 4 * n);
            }
#pragma unroll
            for (int m = 0; m < 4; ++m) {
                float* yo = p.out + off[m];
#pragma unroll
                for (int bj = 0; bj < 2; ++bj)
#pragma unroll
                    for (int n = 0; n < 2; ++n) *(f32x4*)(yo + u.pn * 256 + 128 * bj + 32 * wc + 8 * fq + 4 * n) = xv[m][bj][n] + acc[ai][bj][m][n] * rsv[m];
            }
            asm volatile("" ::: "memory");
        }
    }
};

DEVI void phase1(const P& p, PG8_LAS unsigned char* lds) {
    pg8::Gemm g{(const bf16_t*)(p.ws + W_XB), (const bf16_t*)(p.ws + W_WINT), 1024, 1024, 1024};
    pg8::StaticOrder S; S.init(NROWS_PAD, 2304, gridDim.x, blockIdx.x);
    EpiP1 E{p};
    pg8::gemm_phase<EpiP1, pg8::StaticOrder>(lds, g, S, E);
    const int n3 = 621 - 2 * (int)gridDim.x;
    if ((int)blockIdx.x >= n3) deferred_prep(p, ((int)blockIdx.x - n3) * 512 + tidx(), ((int)gridDim.x - n3) * 512);
}
template <bool FIRST>
struct EpiOutHalf {
    static constexpr bool HAS_MID = false;
    P p;
    DEVI void begin(const pg8::Unit& u, int ui, int tid, PG8_LAS unsigned char* lds) const {
        if (tid < 256) {
            const int row = u.pm * 256 + tid;
            const float* ssq = (const float*)(p.ws + (FIRST ? W_SSQA : W_SSQS)) + (size_t)row * 8;
            const f32x4 a0 = *(const f32x4*)(ssq), a1 = *(const f32x4*)(ssq + 4);
            ((PG8_LAS float*)(lds + LDS_TAB))[(ui & 1) * 256 + tid] = rsqrtf(((a0[0] + a0[1]) + (a0[2] + a0[3]) + (a1[0] + a1[1]) + (a1[2] + a1[3])) * (1.f / 512.f) + EPS);
        }
    }
    DEVI void mid(f32x4 (&)[2][2][4][2], int, int, int, PG8_LAS unsigned char*) const {}
    DEVI void operator()(AccRef acc, const pg8::Unit& u, int wr, int wc, int fr, int fq, int ui, PG8_LAS unsigned char* lds) const {
#pragma unroll
        for (int ai = 0; ai < 2; ++ai)
#pragma unroll
            for (int m = 0; m < 4; ++m) {
                const int rl = ai * 128 + wr * 64 + m * 16 + fr, row = u.pm * 256 + rl;
                const float rsv = ((const PG8_LAS float*)(lds + LDS_TAB))[(ui & 1) * 256 + rl];
                const size_t o = (size_t)(row - 16384) * 1024; const float* xr = p.x_sample + o; float* yo = p.out + O_YS + o;
#pragma unroll
                for (int bj = 0; bj < 2; ++bj)
#pragma unroll
                    for (int n = 0; n < 2; ++n) { const int f = u.pn * 256 + 128 * bj + 32 * wc + 8 * fq + 4 * n;
                        const f32x4 base = FIRST ? *(const f32x4*)(xr + f) : *(const f32x4*)(yo + f); *(f32x4*)(yo + f) = base + acc[ai][bj][m][n] * rsv; }
                asm volatile("" ::: "memory");
            }
    }
};
struct SchedOne { int pm, pn; DEVI bool next(int i, pg8::Unit& u) const { if (i != 0) return false; u.pm = pm; u.pn = pn; return true; } };
DEVI void glu_unit(const P& p, PG8_LAS unsigned char* lds, int pm, int pn) {
    pg8::Gemm g{gb_base(p.ws, pm >= 64), (const bf16_t*)(p.ws + W_WGLUT), 512, 512, 512}; SchedOne S{pm, pn}; EpiGlu E{p};
    pg8::gemm_phase<EpiGlu, SchedOne>(lds, g, S, E);
}
DEVI void out_unit(const P& p, PG8_LAS unsigned char* lds, int pm, int pn) {
    pg8::Gemm g{(const bf16_t*)(p.ws + W_CAT), (const bf16_t*)(p.ws + W_WOUTT), 1024, 1024, 1024}; SchedOne S{pm, pn}; EpiOut E{p};
    pg8::gemm_phase<EpiOut, SchedOne>(lds, g, S, E);
}
template <bool FIRST>
DEVI void out_half_unit(const P& p, PG8_LAS unsigned char* lds, int pm, int pn) {
    pg8::Gemm g{(const bf16_t*)(p.ws + W_CAT) + (FIRST ? 0 : 512), (const bf16_t*)(p.ws + W_WOUTT) + (FIRST ? 0 : 512), 1024, 1024, 512}; SchedOne S{pm, pn}; EpiOutHalf<FIRST> E{p};
    pg8::gemm_phase<EpiOutHalf<FIRST>, SchedOne>(lds, g, S, E);
}
DEVI void phase2b_gemm(const P& p, PG8_LAS unsigned char* lds) {
    const int c = blockIdx.x;
    if (c >= 248) glu_unit(p, lds, 64 + ((c - 248) >> 1), (c - 248) & 1);
    else out_half_unit<true>(p, lds, 64 + ((c - 232) >> 2), (c - 232) & 3);
}
DEVI void phase3a(const P& p, PG8_LAS unsigned char* lds) {
    const int c = blockIdx.x;
    if (c < 128) { const int x = c & 7, s = c >> 3; glu_unit(p, lds, x * 8 + (s >> 1), s & 1); }
    else if (c < 144) out_half_unit<false>(p, lds, 64 + ((c - 128) >> 2), (c - 128) & 3);
}
DEVI void phase3b(const P& p, PG8_LAS unsigned char* lds) { const int c = blockIdx.x, x = c & 7, s = c >> 3; out_unit(p, lds, x * 8 + (s >> 2), s & 3); }

__global__ void __launch_bounds__(512, 2) hymba_fwd(P p) {
    extern __shared__ __attribute__((aligned(16))) unsigned char lds_dyn[];
    PG8_LAS unsigned char* lds = (PG8_LAS unsigned char*)lds_dyn;
    if (threadIdx.x < 16) ((PG8_LAS unsigned*)(lds + LDS_XB))[threadIdx.x] = 0u;
    __syncthreads();
    XcdBarrier xb = xcd_barrier_post((unsigned*)(p.ws + W_BAR), (volatile LAS unsigned*)(lds + LDS_XB));
#ifndef REP0
#define REP0 1
#define REP1 1
#define REP2A 1
#define REP2B 1
#define REP3A 1
#define REP3B 1
#endif
    for (int r = 0; r < REP0; ++r) { phase0(p); xcd_barrier(xb); }
    for (int r = 0; r < REP1; ++r) { phase1(p, lds); xcd_barrier(xb); }
    for (int r = 0; r < REP2A; ++r) { phase2a(p, (char*)lds_dyn); xcd_barrier(xb); }
    if (blockIdx.x < 232) phase2b(p, (char*)lds_dyn); else phase2b_gemm(p, lds);
    xcd_barrier(xb);
    for (int r = 0; r < REP3A; ++r) { phase3a(p, lds); xcd_barrier(xb); }
    for (int r = 0; r < REP3B; ++r) { phase3b(p, lds); if (r + 1 < REP3B) xcd_barrier(xb); }
}

extern "C" void kernel_launch(void* const* d_in, const int* in_sizes, int n_in, void* d_out, int out_size, void* d_ws, size_t ws_size, hipStream_t stream) {
    P p{};
    const float** pp = (const float**)&p;
    for (int i = 0; i < 25; ++i) pp[i] = (const float*)d_in[i];
    p.out = (float*)d_out; p.ws = (char*)d_ws;
    static int grid_blocks = 0;
    if (!grid_blocks) {
        int dev = 0, cus = 0, per_cu = 0;
        (void)hipGetDevice(&dev);
        (void)hipDeviceGetAttribute(&cus, hipDeviceAttributeMultiprocessorCount, dev);
        (void)hipFuncSetAttribute((const void*)hymba_fwd, hipFuncAttributeMaxDynamicSharedMemorySize, LDS_BYTES);
        (void)hipOccupancyMaxActiveBlocksPerMultiprocessor(&per_cu, hymba_fwd, 512, LDS_BYTES);
        if (per_cu < 1) fprintf(stderr, "occupancy query reports %d blocks per CU\n", per_cu);
        grid_blocks = cus;
    }
    (void)hipMemsetAsync((char*)d_ws + W_BAR, 0, 16384, stream);
    void* args[] = {&p};
    hipError_t e = hipLaunchCooperativeKernel((void*)hymba_fwd, dim3(grid_blocks), dim3(512), args, LDS_BYTES, stream);
    if (e != hipSuccess) fprintf(stderr, "cooperative launch failed: %s (grid %d)\n", hipGetErrorString(e), grid_blocks);
}
```

```cpp
#include <hip/hip_runtime.h>
#include <hip/hip_cooperative_groups.h>
#include <cstdio>
#include <cstdint>
namespace cg = cooperative_groups;

#ifndef SINGLE_LAUNCH
#define SINGLE_LAUNCH 1
#endif

#define DEVI __device__ __forceinline__
typedef unsigned short bf16_t;
typedef short bf16x8 __attribute__((ext_vector_type(8)));
typedef float f32x4 __attribute__((ext_vector_type(4)));
typedef float f32x16 __attribute__((ext_vector_type(16)));
typedef unsigned u32x2 __attribute__((ext_vector_type(2)));
typedef float f32x2 __attribute__((ext_vector_type(2)));
typedef unsigned u32x4 __attribute__((ext_vector_type(4)));

constexpr int LP = 8208;
constexpr int NPR = 2 * LP;
constexpr int NROWS = NPR + 1024;
constexpr int NROWS_PAD = 17664;
constexpr int NBLK = 514 + 640;
constexpr float EPS = 1e-6f;
constexpr float LOG2E = 1.4426950408889634f;
constexpr float QSCALE = 0.125f * LOG2E;

constexpr size_t O_YP = 0, O_YS = 16777216, O_KWP = 17825792, O_VWP = 17858560, O_SRP = 17891328, O_SIP = 17895424,
                 O_KNS = 17899520, O_VNS = 18030592, O_SRS = 18161664, O_SIS = 18423808;

constexpr size_t al256(size_t x) { return (x + 255) & ~(size_t)255; }
constexpr size_t W_BAR = 0;
constexpr size_t W_XB = 16384;
constexpr size_t W_RS = al256(W_XB + (size_t)NROWS_PAD * 1024 * 2);
constexpr size_t W_WINT = al256(W_RS + (size_t)NROWS_PAD * 4);
constexpr size_t W_WGLUT = al256(W_WINT + (size_t)2304 * 1024 * 2);
constexpr size_t W_WOUTT = al256(W_WGLUT + (size_t)512 * 512 * 2);
constexpr size_t W_ROPE = al256(W_WOUTT + (size_t)1024 * 1024 * 2);
constexpr size_t W_LAM = al256(W_ROPE + (size_t)LP * 32 * 8);
constexpr size_t W_LAM64 = al256(W_LAM + 32 * 64 * 8);
constexpr size_t W_BBARF = al256(W_LAM64 + 32 * 64 * 8);
constexpr size_t W_CMF = al256(W_BBARF + 32 * 4 * 64 * 8 * 2);
constexpr size_t W_QB = al256(W_CMF + 32 * 4 * 64 * 8 * 2);
constexpr size_t W_KF = al256(W_QB + (size_t)NROWS_PAD * 512 * 2);
constexpr size_t W_VF = al256(W_KF + (size_t)2 * NBLK * 4 * 64 * 8 * 2);
constexpr size_t W_GA = al256(W_VF + (size_t)2 * NBLK * 4 * 64 * 8 * 2);
constexpr size_t W_GS = al256(W_GA + (size_t)NROWS_PAD * 512 * 2);
constexpr size_t W_UG = al256(W_GS + (size_t)NROWS_PAD * 512 * 2);
constexpr size_t W_CAT = W_XB;
constexpr size_t W_SSQA = al256(W_UG + (size_t)NROWS_PAD * 512 * 2);
constexpr size_t W_GB = W_QB;
constexpr size_t W_GBS = al256(W_SSQA + (size_t)NROWS_PAD * 8 * 4);
constexpr size_t W_SSQS = al256(W_GBS + (size_t)1024 * 512 * 2);
DEVI bf16_t* gb_base(char* ws, bool sample_rows) { return sample_rows ? (bf16_t*)(ws + W_GBS) - (size_t)16384 * 512 : (bf16_t*)(ws + W_GB); }
constexpr size_t W_ENDS = al256(W_SSQS + (size_t)NROWS_PAD * 8 * 4);
constexpr size_t W_CARRY = al256(W_ENDS + (size_t)2 * 32 * 128 * 64 * 8);
constexpr size_t W_TOTAL = al256(W_CARRY + (size_t)2 * 32 * 129 * 64 * 8);

constexpr int LDS_XB = 131072 + 4096;
constexpr int LDS_BYTES = LDS_XB + 64;

struct P {
    const float *x_prompt, *x_sample, *cache_k, *cache_v, *st_re, *st_im, *meta, *norm_w, *w_in, *q_norm_w, *k_norm_w, *sinks,
        *aon_w, *A_re, *A_im, *log_dt, *B_re, *B_im, *C_re, *C_im, *Dk, *w_glu, *b_glu, *son_w, *w_out;
    float* out;
    char* ws;
};

DEVI int tidx() { int t = threadIdx.x; asm volatile("" : "+v"(t)); return t; }
constexpr int NROWS3 = 17408;
DEVI int row3_of(int row) {
    if (row >= NPR) return 16384 + (row - NPR);
    const int b = row >= LP ? 1 : 0, pos = row - b * LP;
    return pos >= 16 ? b * 8192 + pos - 16 : NROWS3 + b * 16 + pos;
}
typedef __bf16 bf16x2_t __attribute__((ext_vector_type(2)));
DEVI unsigned pk2(float lo, float hi) { const f32x2 v = {lo, hi}; const bf16x2_t b = __builtin_convertvector(v, bf16x2_t); return __builtin_bit_cast(unsigned, b); }
DEVI bf16_t f2bf(float f) { return (bf16_t)(pk2(f, 0.f) & 0xffffu); }
DEVI float bf2f(unsigned short b) { return __uint_as_float(((unsigned)b) << 16); }
DEVI float bflo(unsigned w) { return __uint_as_float(w << 16); }
DEVI float bfhi(unsigned w) { return __uint_as_float(w & 0xffff0000u); }
DEVI float silu_f(float x) { return x * __builtin_amdgcn_rcpf(1.f + __expf(-x)); }
DEVI float sigmoid_f(float x) { return __builtin_amdgcn_rcpf(1.f + __expf(-x)); }
DEVI float gelu_tanh(float x) {
    const float u = 1.5957691216057308f * (x + 0.044715f * x * x * x);
    return x * __builtin_amdgcn_rcpf(1.f + __expf(-u));
}
DEVI f32x4 mfma16(bf16x8 a, bf16x8 b, f32x4 c) { return __builtin_amdgcn_mfma_f32_16x16x32_bf16(a, b, c, 0, 0, 0); }
DEVI f32x16 mfma32(bf16x8 a, bf16x8 b, f32x16 c) { return __builtin_amdgcn_mfma_f32_32x32x16_bf16(a, b, c, 0, 0, 0); }
DEVI bf16x8 mk8(unsigned a, unsigned b, unsigned c, unsigned d) { u32x4 t = {a, b, c, d}; return __builtin_bit_cast(bf16x8, t); }


#define XB_TMO      128
#define XB_XCNT(j)  (256  + 64 * (j))
#define XB_XSUB(j)  (1280 + 64 * (j))
#define XB_XGEN(j)  (2304 + 64 * (j))
#define XB_TOP      3328
#define XB_TOPGEN   3392
#define XCD_BAR_WORDS 3456
#define XB_SPIN_CAP (1u << 18)
#define LAS __attribute__((address_space(3)))
DEVI unsigned xb_ld(unsigned* p) { return __hip_atomic_load(p, __ATOMIC_RELAXED, __HIP_MEMORY_SCOPE_AGENT); }
DEVI unsigned xb_add(unsigned* p, unsigned v) { return __hip_atomic_fetch_add(p, v, __ATOMIC_RELAXED, __HIP_MEMORY_SCOPE_AGENT); }
DEVI unsigned xb_xcc_id() { return (unsigned)__builtin_amdgcn_s_getreg((3 << 11) | 20) & 0xFu; }
#define XB_SPIN(cond, bar) do { unsigned _sp = 0; while (cond) { __builtin_amdgcn_s_sleep(1); \
    if ((++_sp & 255u) == 0u) { if (xb_ld(&(bar)[XB_TMO])) break; if (_sp > XB_SPIN_CAP) { atomicAdd(&(bar)[XB_TMO], 1u); break; } } } } while (0)
struct XcdBarrier { unsigned* bar; unsigned x; volatile LAS unsigned* st; };
DEVI XcdBarrier xcd_barrier_post(unsigned* bar, volatile LAS unsigned* st) {
    XcdBarrier b; b.bar = bar; b.x = xb_xcc_id(); b.st = st;
    if (tidx() == 0) (void)xb_add(&bar[XB_XCNT(b.x)], 1u);
    return b;
}
DEVI void xcd_barrier_complete(unsigned* bar, unsigned x, unsigned& nloc, unsigned& nx) {
    const unsigned G = gridDim.x * gridDim.y * gridDim.z;
    unsigned sum, cnt, mine, sp = 0u;
    for (;;) {
        sum = 0u; cnt = 0u; mine = 0u;
#pragma unroll
        for (unsigned j = 0; j < 16; ++j) { const unsigned c = xb_ld(&bar[XB_XCNT(j)]); sum += c; cnt += (c > 0u) ? 1u : 0u; mine = (j == x) ? c : mine; }
        if (sum == G) break;
        __builtin_amdgcn_s_sleep(1);
        if ((++sp & 255u) == 0u) { if (xb_ld(&bar[XB_TMO])) break; if (sp > XB_SPIN_CAP) { atomicAdd(&bar[XB_TMO], 1u); break; } }
    }
    nloc = mine > 0u ? mine : 1u; nx = cnt > 0u ? cnt : 1u;
}
DEVI void xcd_barrier(const XcdBarrier& b) {
    asm volatile("s_waitcnt vmcnt(0)" ::: "memory");
    __syncthreads();
    if (tidx() == 0) {
        unsigned* bar = b.bar;
        __builtin_amdgcn_s_waitcnt(0);
        unsigned nloc = b.st[0], nx = b.st[1];
        if (nloc == 0u) { xcd_barrier_complete(bar, b.x, nloc, nx); b.st[0] = nloc; b.st[1] = nx; }
        const unsigned old = xb_add(&bar[XB_XSUB(b.x)], 1u);
        const unsigned gen = old / nloc;
        if (old + 1u == (gen + 1u) * nloc) {
            __builtin_amdgcn_fence(__ATOMIC_RELEASE, "agent");
            asm volatile("s_waitcnt vmcnt(0)" ::: "memory");
            const unsigned og = xb_add(&bar[XB_TOP], 1u);
            const unsigned tg = og / nx;
            if (og + 1u == (tg + 1u) * nx) xb_add(&bar[XB_TOPGEN], 1u);
            else XB_SPIN(xb_ld(&bar[XB_TOPGEN]) == tg, bar);
            __builtin_amdgcn_fence(__ATOMIC_ACQUIRE, "agent");
            xb_add(&bar[XB_XGEN(b.x)], 1u);
            asm volatile("s_waitcnt vmcnt(0)" ::: "memory");
        } else {
            XB_SPIN(xb_ld(&bar[XB_XGEN(b.x)]) == gen, bar);
            __builtin_amdgcn_fence(__ATOMIC_ACQUIRE, "agent");
            asm volatile("s_waitcnt vmcnt(0)" ::: "memory");
        }
    }
    __syncthreads();
}

DEVI const float* row_src(const P& p, int r) {
    if (r < NPR) { const int b = r >= LP ? 1 : 0, pos = r - b * LP; return pos < 16 ? p.meta + (size_t)pos * 1024 : p.x_prompt + ((size_t)b * 8192 + pos - 16) * 1024; }
    if (r < NROWS) return p.x_sample + (size_t)(r - NPR) * 1024;
    return nullptr;
}

DEVI void p0_ssm_f(const P& p, int i, float& fre, float& fim, float2& lamv, float2& lam64v) {
    const int g = i >> 6;
    const double dt = exp((double)p.log_dt[g]), are = p.A_re[i], aim = p.A_im[i];
    const double mag = exp(dt * are);
    double th = dt * aim * 0.15915494309189535; th -= rint(th); th *= 6.283185307179586;
    const float thf = (float)th; const float sh = sinf(0.5f * thf);
    const double lr = mag * (double)cosf(thf), li = mag * (double)sinf(thf);
    const double lrm1 = expm1(dt * are) - mag * 2.0 * (double)sh * (double)sh;
    lamv = make_float2((float)lr, (float)li);
    const double mag64 = exp(64.0 * dt * are);
    double th64 = 64.0 * dt * aim * 0.15915494309189535; th64 -= rint(th64); th64 *= 6.283185307179586;
    lam64v = make_float2((float)(mag64 * (double)cosf((float)th64)), (float)(mag64 * (double)sinf((float)th64)));
    const double den = are * are + aim * aim;
    fre = (float)((lrm1 * are + li * aim) / den); fim = (float)((li * are - lrm1 * aim) / den);
}

DEVI void phase0(const P& p) {
    const int gtid = blockIdx.x * 512 + tidx(), gsz = gridDim.x * 512;
    const int gw = gtid >> 6, nw = gsz >> 6, lane = tidx() & 63;
    bf16_t* xb = (bf16_t*)(p.ws + W_XB); float* rs = (float*)(p.ws + W_RS);
    for (int r = gw * 2; r < NROWS_PAD; r += nw * 2) {
        const float* src0 = row_src(p, r); const float* src1 = row_src(p, r + 1);
        f32x4 v[2][4]; float ss0 = 0.f, ss1 = 0.f;
#pragma unroll
        for (int i = 0; i < 4; ++i) {
            v[0][i] = src0 ? *(const f32x4*)(src0 + (i * 64 + lane) * 4) : (f32x4){0.f, 0.f, 0.f, 0.f};
            v[1][i] = src1 ? *(const f32x4*)(src1 + (i * 64 + lane) * 4) : (f32x4){0.f, 0.f, 0.f, 0.f};
        }
#pragma unroll
        for (int i = 0; i < 4; ++i) {
            ss0 += v[0][i][0] * v[0][i][0] + v[0][i][1] * v[0][i][1] + v[0][i][2] * v[0][i][2] + v[0][i][3] * v[0][i][3];
            ss1 += v[1][i][0] * v[1][i][0] + v[1][i][1] * v[1][i][1] + v[1][i][2] * v[1][i][2] + v[1][i][3] * v[1][i][3];
        }
#pragma unroll
        for (int o = 32; o >= 1; o >>= 1) { ss0 += __shfl_xor(ss0, o); ss1 += __shfl_xor(ss1, o); }
        if (lane == 0) { rs[r] = rsqrtf(ss0 * (1.f / 1024.f) + EPS); rs[r + 1] = rsqrtf(ss1 * (1.f / 1024.f) + EPS); }
#pragma unroll
        for (int i = 0; i < 4; ++i) {
            u32x2 w0 = {pk2(v[0][i][0], v[0][i][1]), pk2(v[0][i][2], v[0][i][3])}; *(u32x2*)(xb + (size_t)r * 1024 + (i * 64 + lane) * 4) = w0;
            u32x2 w1 = {pk2(v[1][i][0], v[1][i][1]), pk2(v[1][i][2], v[1][i][3])}; *(u32x2*)(xb + (size_t)(r + 1) * 1024 + (i * 64 + lane) * 4) = w1;
        }
    }
    bf16_t* winT = (bf16_t*)(p.ws + W_WINT);
    for (int i = gtid; i < 2304 * 128; i += gsz) {
        const int n = i % 2304, k8 = i / 2304; float t[8];
        const int f = (n & ~255) + ((n >> 5) & 3) * 64 + ((n >> 7) & 1) * 32 + (n & 31);
#pragma unroll
        for (int j = 0; j < 8; ++j) t[j] = p.w_in[(size_t)(k8 * 8 + j) * 2304 + f] * p.norm_w[k8 * 8 + j];
        u32x4 w = {pk2(t[0], t[1]), pk2(t[2], t[3]), pk2(t[4], t[5]), pk2(t[6], t[7])};
        *(u32x4*)(winT + (size_t)n * 1024 + k8 * 8) = w;
    }
    {
        bf16_t* kF = (bf16_t*)(p.ws + W_KF); bf16_t* vF = (bf16_t*)(p.ws + W_VF);
        for (int i = gtid; i < 2 * 130 * 256; i += gsz) {
            const int piece = i & 255, s = (i >> 8) % 130, kvh = (i >> 8) / 130;
            const int blk = s < 2 ? s * 257 + 256 : 514 + (s - 2) * 5 + 4;
            const u32x4 z = {0u, 0u, 0u, 0u};
            *(u32x4*)(kF + (size_t)(kvh * NBLK + blk) * 2048 + piece * 8) = z;
            *(u32x4*)(vF + (size_t)(kvh * NBLK + blk) * 2048 + piece * 8) = z;
        }
    }
    float2* rope = (float2*)(p.ws + W_ROPE);
    for (int i = gtid; i < LP * 32; i += gsz) {
        const int pos = i >> 5, d = i & 31;
        const double inv = exp2(-(double)d * (13.287712379549449 / 32.0));
        double t = (double)pos * inv * 0.15915494309189535; t -= rint(t);
        const float r = (float)(t * 6.283185307179586);
        rope[i] = make_float2(cosf(r), sinf(r));
    }
}

DEVI void deferred_prep(const P& p, int gtid, int gsz) {
    bf16_t* wgT = (bf16_t*)(p.ws + W_WGLUT);
    for (int i = gtid; i < 512 * 64; i += gsz) {
        const int n = i % 512, k8 = i / 512; float t[8];
#pragma unroll
        for (int j = 0; j < 8; ++j) t[j] = p.w_glu[(size_t)(k8 * 8 + j) * 512 + n];
        u32x4 w = {pk2(t[0], t[1]), pk2(t[2], t[3]), pk2(t[4], t[5]), pk2(t[6], t[7])};
        *(u32x4*)(wgT + (size_t)n * 512 + k8 * 8) = w;
    }
    bf16_t* woT = (bf16_t*)(p.ws + W_WOUTT);
    for (int i = gtid; i < 1024 * 128; i += gsz) {
        const int n = i % 1024, k8 = i / 1024; float t[8];
#pragma unroll
        for (int j = 0; j < 8; ++j) { const int k = k8 * 8 + j; t[j] = p.w_out[(size_t)k * 1024 + n] * (k < 512 ? p.aon_w[k] : p.son_w[k - 512]); }
        u32x4 w = {pk2(t[0], t[1]), pk2(t[2], t[3]), pk2(t[4], t[5]), pk2(t[6], t[7])};
        *(u32x4*)(woT + (size_t)n * 1024 + k8 * 8) = w;
    }
    {
        bf16_t* kF = (bf16_t*)(p.ws + W_KF); bf16_t* vF = (bf16_t*)(p.ws + W_VF);
        for (int i = gtid; i < 2 * 128 * 4 * 4 * 64; i += gsz) {
            const int ln = i & 63, ks = (i >> 6) & 3, kb = (i >> 8) & 3, db = (i >> 10) & 127, kvh = i >> 17;
            const float* kp = p.cache_k + ((size_t)(db * 128 + kb * 32 + (ln & 31)) * 2 + kvh) * 64 + ks * 16 + (ln >> 5) * 8;
            const f32x4 a = *(const f32x4*)kp, c = *(const f32x4*)(kp + 4);
            u32x4 w = {pk2(a[0], a[1]), pk2(a[2], a[3]), pk2(c[0], c[1]), pk2(c[2], c[3])};
            *(u32x4*)(kF + ((size_t)((kvh * NBLK + 514 + db * 5 + kb) * 4 + ks) * 64 + ln) * 8) = w;
            const int db2 = ks >> 1, s2 = ks & 1, h = ln >> 5; float t[8];
#pragma unroll
            for (int j = 0; j < 8; ++j) { const int key = 16 * s2 + 8 * (j >> 2) + 4 * h + (j & 3);
                t[j] = p.cache_v[((size_t)(db * 128 + kb * 32 + key) * 2 + kvh) * 64 + db2 * 32 + (ln & 31)]; }
            u32x4 wv = {pk2(t[0], t[1]), pk2(t[2], t[3]), pk2(t[4], t[5]), pk2(t[6], t[7])};
            *(u32x4*)(vF + ((size_t)(((kvh * NBLK + 514 + db * 5 + kb) * 2 + db2) * 2 + s2) * 64 + ln) * 8) = wv;
        }
    }
    float2* lam = (float2*)(p.ws + W_LAM); float2* lam64 = (float2*)(p.ws + W_LAM64);
    bf16_t* bbarF = (bf16_t*)(p.ws + W_BBARF); bf16_t* cmF = (bf16_t*)(p.ws + W_CMF);
    for (int e = gsz - 1 - gtid; e < 32 * 64 * 16; e += gsz) {
        const int i = e >> 4, h = e & 15, g = i >> 6, n = i & 63;
        float fre, fim; float2 lv, l64v; p0_ssm_f(p, i, fre, fim, lv, l64v);
        if (h == 0) { lam[i] = lv; lam64[i] = l64v; }
        const float Br = p.B_re[(size_t)i * 16 + h], Bi = p.B_im[(size_t)i * 16 + h];
        const float bre = fre * Br - fim * Bi, bim = fre * Bi + fim * Br;
        const int cf0 = (n >= 32 ? 2 : 0), ln = (h >> 3) * 32 + (n & 31), j = h & 7;
        bbarF[((size_t)(g * 4 + cf0) * 64 + ln) * 8 + j] = f2bf(bre);
        bbarF[((size_t)(g * 4 + cf0 + 1) * 64 + ln) * 8 + j] = f2bf(bim);
        const int ho = h;
        const float cre = p.C_re[(size_t)(g * 16 + ho) * 64 + n], cim = p.C_im[(size_t)(g * 16 + ho) * 64 + n];
#pragma unroll
        for (int part = 0; part < 2; ++part) {
            const int kk = 2 * n + part, ks = kk >> 5, q = (kk & 31) >> 3, jj = kk & 7, ln2 = q * 16 + ho;
            cmF[((size_t)(g * 4 + ks) * 64 + ln2) * 8 + jj] = f2bf(part ? -cim : cre);
        }
    }
}

template <bool SAMPLE>
DEVI int attn_blk(int kb, int ia, int b, int q0) {
    if (SAMPLE) return 514 + ia * 5 + kb;
    int kpos0 = q0 - 128 + 32 * kb; kpos0 = kpos0 < 0 ? 0 : kpos0;
    return b * 257 + (kpos0 >> 5);
}
DEVI void attn_load_k(const P& p, int blk, int kvh, int lane, bf16x8 (&kfr)[4]) {
    const bf16_t* kF = (const bf16_t*)(p.ws + W_KF);
#pragma unroll
    for (int ks = 0; ks < 4; ++ks) kfr[ks] = *(const bf16x8*)(kF + ((size_t)((kvh * NBLK + blk) * 4 + ks) * 64 + lane) * 8);
}
DEVI void attn_load_v(const P& p, int blk, int kvh, int lane, bf16x8 (&vfr)[2][2]) {
    const bf16_t* vF = (const bf16_t*)(p.ws + W_VF);
#pragma unroll
    for (int db2 = 0; db2 < 2; ++db2)
#pragma unroll
        for (int s2 = 0; s2 < 2; ++s2) vfr[db2][s2] = *(const bf16x8*)(vF + ((size_t)(((kvh * NBLK + blk) * 2 + db2) * 2 + s2) * 64 + lane) * 8);
}

template <bool SAMPLE>
DEVI void attn_unit(const P& p, int ia, int ib, int ic) {
    const int lane = tidx() & 63, c5 = lane & 31, h = lane >> 5;
    const bf16_t* qb = (const bf16_t*)(p.ws + W_QB);
    int rowq, head, kvh, b = 0, q0 = 0; bool qok;
    if (SAMPLE) { const int db = ia; kvh = ib; head = kvh * 4 + (c5 & 3); rowq = NPR + db * 8 + (c5 >> 2); qok = true; }
    else { b = ia; head = ib; kvh = head >> 2; q0 = ic * 32; rowq = b * LP + q0 + c5; qok = (q0 + c5) < LP; }
    bf16x8 kfr[5][4], vfr[3][2][2];
#pragma unroll
    for (int kb = 0; kb < 5; ++kb) attn_load_k(p, attn_blk<SAMPLE>(kb, ia, b, q0), kvh, lane, kfr[kb]);
    bf16x8 qf[4];
#pragma unroll
    for (int ks = 0; ks < 4; ++ks) qf[ks] = *(const bf16x8*)(qb + (size_t)rowq * 512 + head * 64 + ks * 16 + h * 8);
#pragma unroll
    for (int kb = 0; kb < 3; ++kb) attn_load_v(p, attn_blk<SAMPLE>(kb, ia, b, q0), kvh, lane, vfr[kb]);
    float m = p.sinks[head] * LOG2E, lsum = h == 0 ? 1.f : 0.f;
    f32x16 O[2];
#pragma unroll
    for (int i = 0; i < 16; ++i) { O[0][i] = 0.f; O[1][i] = 0.f; }
    const int tq = SAMPLE ? (c5 >> 2) : c5;
    auto body = [&](int kb, const bf16x8 (&kf)[4], const bf16x8 (&vf)[2][2]) {
        const bool blk_ok = SAMPLE ? true : (q0 - 128 + 32 * kb) >= 0;
        f32x16 S;
#pragma unroll
        for (int i = 0; i < 16; ++i) S[i] = 0.f;
#pragma unroll
        for (int ks = 0; ks < 4; ++ks) S = mfma32(kf[ks], qf[ks], S);
        float mx = -3.0e38f;
#pragma unroll
        for (int i = 0; i < 16; ++i) {
            const int ki = (i & 3) + 8 * (i >> 2) + 4 * h;
            bool valid = blk_ok;
            if (kb == 0) valid = valid && (ki > tq); else if (kb == 4) valid = valid && (ki <= tq);
            S[i] = valid ? S[i] : -3.0e38f;
            mx = fmaxf(mx, S[i]);
        }
        mx = fmaxf(mx, __shfl_xor(mx, 32));
        const float mnew = fmaxf(m, mx), alpha = exp2f(m - mnew); m = mnew;
        float ps = 0.f; float pv[16];
#pragma unroll
        for (int i = 0; i < 16; ++i) { pv[i] = exp2f(S[i] - mnew); ps += pv[i]; }
        lsum = lsum * alpha + ps;
#pragma unroll
        for (int i = 0; i < 16; ++i) { O[0][i] *= alpha; O[1][i] *= alpha; }
        const bf16x8 pf0 = mk8(pk2(pv[0], pv[1]), pk2(pv[2], pv[3]), pk2(pv[4], pv[5]), pk2(pv[6], pv[7]));
        const bf16x8 pf1 = mk8(pk2(pv[8], pv[9]), pk2(pv[10], pv[11]), pk2(pv[12], pv[13]), pk2(pv[14], pv[15]));
#pragma unroll
        for (int db2 = 0; db2 < 2; ++db2) { O[db2] = mfma32(vf[db2][0], pf0, O[db2]); O[db2] = mfma32(vf[db2][1], pf1, O[db2]); }
    };
    body(0, kfr[0], vfr[0]);
    attn_load_v(p, attn_blk<SAMPLE>(3, ia, b, q0), kvh, lane, vfr[0]);
    body(1, kfr[1], vfr[1]);
    attn_load_v(p, attn_blk<SAMPLE>(4, ia, b, q0), kvh, lane, vfr[1]);
    body(2, kfr[2], vfr[2]);
    body(3, kfr[3], vfr[0]);
    body(4, kfr[4], vfr[1]);
    lsum += __shfl_xor(lsum, 32);
    const float inv = 1.f / lsum;
    const bf16_t* ga = (const bf16_t*)(p.ws + W_GA) + (size_t)rowq * 512 + head * 64;
    const int rowq3 = row3_of(rowq);
    bf16_t* ao = (bf16_t*)(p.ws + W_CAT) + (size_t)rowq3 * 1024 + head * 64;
    float ssq = 0.f;
#pragma unroll
    for (int db2 = 0; db2 < 2; ++db2)
#pragma unroll
        for (int a = 0; a < 4; ++a) {
            const int d0 = db2 * 32 + 8 * a + 4 * h;
            const u32x2 gw = qok ? *(const u32x2*)(ga + d0) : (u32x2){0u, 0u};
            const float g0 = bflo(gw[0]), g1 = bfhi(gw[0]), g2 = bflo(gw[1]), g3 = bfhi(gw[1]);
            const float o0 = O[db2][4 * a] * inv * silu_f(g0), o1 = O[db2][4 * a + 1] * inv * silu_f(g1), o2 = O[db2][4 * a + 2] * inv * silu_f(g2), o3 = O[db2][4 * a + 3] * inv * silu_f(g3);
            ssq += o0 * o0 + o1 * o1 + o2 * o2 + o3 * o3;
            if (qok) { u32x2 w = {pk2(o0, o1), pk2(o2, o3)}; *(u32x2*)(ao + d0) = w; }
        }
    ssq += __shfl_xor(ssq, 32);
    if (qok && h == 0) ((float*)(p.ws + W_SSQA))[(size_t)rowq3 * 8 + head] = ssq;
}

template <bool PASS2, bool FULLV = false>
DEVI void ssm_item(const P& p, char* wlds, bool sample, int ia, int g, int c) {
    const int lane = tidx() & 63, c5 = lane & 31, hh = lane >> 5;
    const bf16_t* uG = (const bf16_t*)(p.ws + W_UG) + (size_t)g * NROWS_PAD * 16;
    const float2* lamT = (const float2*)(p.ws + W_LAM) + g * 64; const float2* lam64T = (const float2*)(p.ws + W_LAM64) + g * 64;
    const float2 l0 = lamT[c5], l1 = lamT[32 + c5];
    int rowbase, nvalid, nrb;
    if (sample) { rowbase = NPR + (2 * ia + hh) * 8; nvalid = 8; nrb = 1; }
    else { const int pos0 = c * 128 + 64 * hh; rowbase = ia * LP + pos0; nvalid = LP - pos0; nvalid = nvalid < 0 ? 0 : (nvalid > 64 ? 64 : nvalid); nrb = c == 64 ? 1 : 4; }
    bf16x8 bfr[4];
#pragma unroll
    for (int cf = 0; cf < 4; ++cf) bfr[cf] = *(const bf16x8*)((const bf16_t*)(p.ws + W_BBARF) + ((size_t)(g * 4 + cf) * 64 + lane) * 8);
    const int ar_ = lane & 31, ahalf_ = (ar_ >> 2) & 1, aidx_ = (ar_ & 3) + 4 * (ar_ >> 3);
    u32x4 uall[4]; u32x2 dall[4][2];
    { int rbase_a, nv_a;
      if (sample) { rbase_a = NPR + (2 * ia + ahalf_) * 8; nv_a = 8; } else { const int pos0 = c * 128 + 64 * ahalf_; rbase_a = ia * LP + pos0; nv_a = LP - pos0; nv_a = nv_a < 0 ? 0 : (nv_a > 64 ? 64 : nv_a); }
#pragma unroll
      for (int rb = 0; rb < 4; ++rb) { const int ti = rb * 16 + aidx_; uall[rb] = (u32x4){0u, 0u, 0u, 0u};
          if (rb < nrb && ti < nv_a) uall[rb] = *(const u32x4*)(uG + (size_t)(rbase_a + ti) * 16 + (lane >> 5) * 8); }
      if (PASS2) {
#pragma unroll
          for (int tb = 0; tb < 2; ++tb) { int rb_base, nv_t;
              if (sample) { rb_base = NPR + (2 * ia + tb) * 8; nv_t = 8; } else { const int pos0 = c * 128 + 64 * tb; rb_base = ia * LP + pos0; nv_t = LP - pos0; nv_t = nv_t < 0 ? 0 : (nv_t > 64 ? 64 : nv_t); }
#pragma unroll
              for (int rb = 0; rb < 4; ++rb) { const int ti = rb * 16 + (lane & 15); dall[rb][tb] = (u32x2){0u, 0u};
                  if (rb < nrb && ti < nv_t) dall[rb][tb] = *(const u32x2*)(uG + (size_t)(rb_base + ti) * 16 + (lane >> 4) * 4); } }
      }
    }
    float x0r = 0.f, x0i = 0.f, x1r = 0.f, x1i = 0.f;
    if (PASS2) {
        if (sample) { const size_t o = ((size_t)(2 * ia + hh) * 32 + g) * 64; x0r = p.st_re[o + c5]; x0i = p.st_im[o + c5]; x1r = p.st_re[o + 32 + c5]; x1i = p.st_im[o + 32 + c5]; }
        else {
            int sc = 2 * c + hh; sc = sc > 128 ? 128 : sc;
            const float2* cy = (const float2*)(p.ws + W_CARRY) + ((size_t)(ia * 32 + g) * 129 + sc) * 64;
            const float2 c0 = cy[c5], c1 = cy[32 + c5];
            x0r = c0.x; x0i = c0.y; x1r = c1.x; x1i = c1.y;
        }
    }
    bf16x8 cfr[4];
    float dsk[4];
    if (PASS2) {
#pragma unroll
        for (int ks = 0; ks < 4; ++ks) cfr[ks] = *(const bf16x8*)((const bf16_t*)(p.ws + W_CMF) + ((size_t)(g * 4 + ks) * 64 + lane) * 8);
        const f32x4 d4 = *(const f32x4*)(p.Dk + g * 16 + (lane >> 4) * 4);
        dsk[0] = d4[0]; dsk[1] = d4[1]; dsk[2] = d4[2]; dsk[3] = d4[3];
    }
#pragma unroll
    for (int rb = 0; rb < 4; ++rb) {
        if (rb >= nrb) break;
        {
          const bf16x8 af = __builtin_bit_cast(bf16x8, uall[rb]);
          f32x16 bu[4];
#pragma unroll
          for (int cf = 0; cf < 4; ++cf) {
#pragma unroll
              for (int i = 0; i < 16; ++i) bu[cf][i] = 0.f;
              bu[cf] = mfma32(af, bfr[cf], bu[cf]);
          }
          const int nv_here = nvalid - rb * 16;
          unsigned* xw = (unsigned*)wlds;
#pragma unroll
          for (int i = 0; i < 16; ++i) {
              const float a = l0.x * x0r - l0.y * x0i + bu[0][i], bq = l0.x * x0i + l0.y * x0r + bu[1][i];
              const float cc = l1.x * x1r - l1.y * x1i + bu[2][i], dq = l1.x * x1i + l1.y * x1r + bu[3][i];
              if (PASS2 && !FULLV) { const bool v = i < nv_here; x0r = v ? a : x0r; x0i = v ? bq : x0i; x1r = v ? cc : x1r; x1i = v ? dq : x1i; }
              else { x0r = a; x0i = bq; x1r = cc; x1i = dq; }
              if (PASS2) { xw[(hh * 16 + i) * 68 + c5] = pk2(x0r, x0i); xw[(hh * 16 + i) * 68 + 32 + c5] = pk2(x1r, x1i); }
          }
        }
        if (PASS2) {
#pragma unroll
            for (int tb = 0; tb < 2; ++tb) {
                f32x4 y = {0.f, 0.f, 0.f, 0.f};
#pragma unroll
                for (int ks = 0; ks < 4; ++ks) {
                    const bf16x8 xf = *(const bf16x8*)(wlds + (tb * 16 + (lane & 15)) * 272 + ks * 64 + (lane >> 4) * 16);
                    y = mfma16(cfr[ks], xf, y);
                }
                int rb_base, nv_t;
                if (sample) { rb_base = NPR + (2 * ia + tb) * 8; nv_t = 8; } else { const int pos0 = c * 128 + 64 * tb; rb_base = ia * LP + pos0; nv_t = LP - pos0; nv_t = nv_t < 0 ? 0 : (nv_t > 64 ? 64 : nv_t); }
                const int ti = rb * 16 + (lane & 15);
                if (ti < nv_t) {
                    const int row = rb_base + ti;
                    const u32x2 uw = dall[rb][tb];
                    const float y0 = y[0] + dsk[0] * bflo(uw[0]), y1 = y[1] + dsk[1] * bfhi(uw[0]), y2 = y[2] + dsk[2] * bflo(uw[1]), y3 = y[3] + dsk[3] * bfhi(uw[1]);
                    u32x2 w = {pk2(gelu_tanh(y0), gelu_tanh(y1)), pk2(gelu_tanh(y2), gelu_tanh(y3))};
                    *(u32x2*)(gb_base(p.ws, sample) + (size_t)row3_of(row) * 512 + g * 16 + (lane >> 4) * 4) = w;
                }
            }
        }
    }
    if (!PASS2) {
        float2* ends = (float2*)(p.ws + W_ENDS) + (size_t)(ia * 32 + g) * 128 * 64 + (size_t)(2 * c + hh) * 64;
        ends[c5] = make_float2(x0r, x0i); ends[32 + c5] = make_float2(x1r, x1i);
    } else {
        if (sample) { const size_t o = ((size_t)(2 * ia + hh) * 32 + g) * 64;
            p.out[O_SRS + o + c5] = x0r; p.out[O_SIS + o + c5] = x0i; p.out[O_SRS + o + 32 + c5] = x1r; p.out[O_SIS + o + 32 + c5] = x1i; }
        else if (c == 64 && hh == 0) { const size_t o = ((size_t)ia * 32 + g) * 64;
            p.out[O_SRP + o + c5] = x0r; p.out[O_SIP + o + c5] = x0i; p.out[O_SRP + o + 32 + c5] = x1r; p.out[O_SIP + o + 32 + c5] = x1i; }
    }
}

DEVI void phase2a(const P& p, char* lds) {
    const int tid = tidx(), wid = tid >> 6, lane = tid & 63;
    if (blockIdx.x < 64) {
        const int bg = blockIdx.x, g = bg & 31, b = bg >> 5;
#pragma unroll 1
        for (int k = 0; k < 8; ++k) ssm_item<false>(p, lds + wid * 8704, false, b, g, wid * 8 + k);
        asm volatile("s_waitcnt vmcnt(0)" ::: "memory");
        __syncthreads();
        const float2 L = ((const float2*)(p.ws + W_LAM64))[g * 64 + lane];
        const float2* ends = (const float2*)(p.ws + W_ENDS) + (size_t)bg * 128 * 64 + (size_t)(16 * wid) * 64 + lane;
        float2 e[16];
#pragma unroll
        for (int s = 0; s < 16; ++s) e[s] = ends[s * 64];
        float xr = 0.f, xi = 0.f;
#pragma unroll
        for (int s = 0; s < 16; ++s) { const float a = L.x * xr - L.y * xi + e[s].x, bq = L.x * xi + L.y * xr + e[s].y; xr = a; xi = bq; }
        float pr = L.x, pi = L.y;
#pragma unroll
        for (int k = 0; k < 4; ++k) { const float a = pr * pr - pi * pi, bq = 2.f * pr * pi; pr = a; pi = bq; }
        float2* seg = (float2*)lds;
        seg[wid * 64 + lane] = make_float2(xr, xi);
        __syncthreads();
        float cr = 0.f, ci = 0.f;
        for (int i = 0; i < wid; ++i) { const float2 q = seg[i * 64 + lane]; const float a = pr * cr - pi * ci + q.x, bq = pr * ci + pi * cr + q.y; cr = a; ci = bq; }
        float2* cy = (float2*)(p.ws + W_CARRY) + (size_t)bg * 129 * 64 + (size_t)(16 * wid) * 64 + lane;
        xr = cr; xi = ci;
#pragma unroll
        for (int s = 0; s < 16; ++s) { cy[s * 64] = make_float2(xr, xi); const float a = L.x * xr - L.y * xi + e[s].x, bq = L.x * xi + L.y * xr + e[s].y; xr = a; xi = bq; }
        if (wid == 7) cy[16 * 64] = make_float2(xr, xi);
        __syncthreads();
    } else {
        const int vb0 = (int)blockIdx.x - 64;
        const int w = ((vb0 & 7) * 24 + (vb0 >> 3)) * 8 + wid;
        for (int u = w; u < 4096; u += 1536) { const int head = u & 7, r = u >> 3, qblk = r & 255, b = r >> 8; attn_unit<false>(p, b, head, qblk); }
        { const int e = w - 1024; if (e >= 0 && e < 16) attn_unit<false>(p, e >> 3, e & 7, 256); }
        { const int s = w - 1024 - 16; if (s >= 0 && s < 256) attn_unit<true>(p, s >> 1, s & 1, 0); }
        if (w < 1296) ssm_item<true>(p, lds + wid * 8704, true, w >> 5, w & 31, 0);
        else for (int u = w; u < 2048; u += 240) ssm_item<true>(p, lds + wid * 8704, true, u >> 5, u & 31, 0);
    }
}
DEVI void phase2b(const P& p, char* lds) {
    const int wid = tidx() >> 6;
    for (int it = blockIdx.x * 8 + wid; it < 4096; it += 232 * 8) { const int c = it & 63, g = (it >> 6) & 31, b = it >> 11; ssm_item<true, true>(p, lds + wid * 8704, false, b, g, c); }
    for (int it = (231 - (int)blockIdx.x) * 8 + wid; it < 64; it += 232 * 8) ssm_item<true, false>(p, lds + wid * 8704, false, it >> 5, it & 31, 64);
}

namespace pg8 {
#define PG8_LAS __attribute__((address_space(3)))
constexpr int BM = 256, BK = 64, HALF = 128, HTB = HALF * BK * 2  , STAGE_BYTES = 8 * HTB, NXCD = 8, WGM = 8;
__host__ __device__ __forceinline__ int lds_byte(int r, int c) { const int st = (r >> 4) * 2 + (c >> 5), rr = r & 15, cc = c & 31, ob = rr * 64 + cc * 2; return st * 1024 + (ob ^ (((ob >> 9) & 1) << 5)); }
__host__ __device__ __forceinline__ void stage_rc(int b, int& R, int& C) { const int st = b / 1024, sb = b % 1024, swz = sb ^ (((sb >> 9) & 1) << 5); R = (st >> 1) * 16 + swz / 64; C = (st & 1) * 32 + (swz % 64) / 2; }
__host__ __device__ __forceinline__ int perm32(int rho) { const int n = rho >> 4, i = rho & 15; return 8 * (i >> 2) + 4 * n + (i & 3); }
struct Unit { int pm, pn; };
struct Gemm { const bf16_t* A; const bf16_t* Bt; int lda, ldb, K; };
struct StaticOrder {
    int nM, nN, nwg, G, c;
    __host__ __device__ void init(int M, int N, int G_, int c_) { nM = M / BM; nN = N / BM; nwg = nM * nN; G = G_; c = c_; }
    __host__ __device__ bool next(int i, Unit& u) const {
        const long L = (long)i * G + c; if (L >= nwg) return false;
        int wgid = (int)L; { const int q = nwg / NXCD, r = nwg % NXCD, xcd = wgid % NXCD, off = wgid / NXCD; wgid = (xcd < r ? xcd * (q + 1) : r * (q + 1) + (xcd - r) * q) + off; }
        const int nig = WGM * nN, gid = wgid / nig, fm = gid * WGM, gsz = (nM - fm) < WGM ? (nM - fm) : WGM;
        u.pm = fm + ((wgid % nig) % gsz); u.pn = (wgid % nig) / gsz; return true;
    }
};
template <class Epi, class Sched>
__device__ __forceinline__ void gemm_phase(PG8_LAS unsigned char* lds, const Gemm g, const Sched& S, const Epi& E) {
    const int tid = tidx(), wid = __builtin_amdgcn_readfirstlane(tid >> 6), lane = tid & 63, wr = wid >> 2, wc = wid & 3, fr = lane & 15, fq = lane >> 4;
    const int K = g.K, nt = K / BK;
    unsigned voffA[2], voffB[2];
#pragma unroll
    for (int i = 0; i < 2; ++i) { int R, C; stage_rc(tid * 16 + i * 8192, R, C); const int Rb = (R & ~31) + perm32(R & 31); voffA[i] = (unsigned)(R * g.lda + C) * 2u; voffB[i] = (unsigned)(Rb * g.ldb + C) * 2u; }
    const size_t kstep = (size_t)(BK * 2);
    const size_t hstepA = (size_t)HALF * g.lda * 2, hstepB = (size_t)HALF * g.ldb * 2;
    const size_t tstepA = 2 * hstepA, tstepB = 2 * hstepB;
    const unsigned ldsw = (unsigned)wid * 1024u;
    const int aoff = lds_byte(wr * 64 + fr, fq * 8), boff = lds_byte(wc * 32 + fr, fq * 8);
#define PG8_SA(b, h) (((b) * 2 + (h)) * HTB)
#define PG8_SB(b, h) ((4 + (b) * 2 + (h)) * HTB)
#define PG8_STAGE(bufoff, gbase, voff) do { _Pragma("unroll") for (int _i = 0; _i < 2; ++_i) \
        __builtin_amdgcn_global_load_lds((const unsigned*)((const char*)(gbase) + (voff)[_i]), (PG8_LAS unsigned*)(lds + (bufoff) + ldsw + _i * 8192), 16, 0, 0); } while (0)
#define PG8_LDA(dst, b, h) do { _Pragma("unroll") for (int m = 0; m < 4; ++m) _Pragma("unroll") for (int k = 0; k < 2; ++k) dst[m][k] = *(const PG8_LAS bf16x8*)(lds + PG8_SA(b, h) + aoff + m * 2048 + k * 1024); } while (0)
#define PG8_LDB(dst, b, h) do { _Pragma("unroll") for (int n = 0; n < 2; ++n) _Pragma("unroll") for (int k = 0; k < 2; ++k) dst[n][k] = *(const PG8_LAS bf16x8*)(lds + PG8_SB(b, h) + boff + n * 2048 + k * 1024); } while (0)
#define PG8_MMA(ai, bj, At, Bt) do { __builtin_amdgcn_s_setprio(1); _Pragma("unroll") for (int m = 0; m < 4; ++m) _Pragma("unroll") for (int n = 0; n < 2; ++n) _Pragma("unroll") for (int k = 0; k < 2; ++k) \
        acc[ai][bj][m][n] = __builtin_amdgcn_mfma_f32_16x16x32_bf16(Bt[n][k], At[m][k], acc[ai][bj][m][n], 0, 0, 0); __builtin_amdgcn_s_setprio(0); } while (0)
#define PG8_WAIT_V(n) asm volatile("s_waitcnt vmcnt(" #n ")" ::: "memory")
#define PG8_WAIT_L(n) asm volatile("s_waitcnt lgkmcnt(" #n ")" ::: "memory")
#define PG8_BAR __builtin_amdgcn_s_barrier()
#define PG8_SCHED __builtin_amdgcn_sched_barrier(0)
    Unit cur, nxt; int ui = 0;
    if (!S.next(0, cur)) return;
    f32x4 acc[2][2][4][2];
#pragma unroll
    for (int a = 0; a < 2; ++a)
#pragma unroll
        for (int b = 0; b < 2; ++b)
#pragma unroll
            for (int m = 0; m < 4; ++m)
#pragma unroll
                for (int n = 0; n < 2; ++n) acc[a][b][m][n] = (f32x4){0.f, 0.f, 0.f, 0.f};
    bf16x8 At[4][2], B0[2][2], B1[2][2];
    const char* cA = (const char*)g.A + (size_t)cur.pm * tstepA; const char* cB = (const char*)g.Bt + (size_t)cur.pn * tstepB;
    E.begin(cur, 0, tid, lds);
    asm volatile("s_waitcnt vmcnt(0) lgkmcnt(0)" ::: "memory");
    PG8_BAR;
    PG8_STAGE(PG8_SB(0, 0), cB, voffB); PG8_STAGE(PG8_SB(0, 1), cB + hstepB, voffB); PG8_STAGE(PG8_SA(0, 0), cA, voffA); PG8_STAGE(PG8_SA(0, 1), cA + hstepA, voffA);
    if (wr == 1) PG8_BAR;
    PG8_WAIT_V(2); PG8_BAR;
    PG8_STAGE(PG8_SB(1, 0), cB + kstep, voffB); PG8_STAGE(PG8_SA(1, 0), cA + kstep, voffA); PG8_STAGE(PG8_SB(1, 1), cB + hstepB + kstep, voffB);
    PG8_WAIT_V(6); PG8_BAR;
    for (;;) {
        const bool has_next = S.next(ui + 1, nxt);
        const char* nA = has_next ? (const char*)g.A + (size_t)nxt.pm * tstepA : cA; const char* nB = has_next ? (const char*)g.Bt + (size_t)nxt.pn * tstepB : cB;
        for (int t = 0; t < nt; t += 2) {
            const bool last = (t == nt - 2);
            const char* a1 = cA + (size_t)(t + 1) * kstep;
            const char* a2 = last ? nA : cA + (size_t)(t + 2) * kstep; const char* b2 = last ? nB : cB + (size_t)(t + 2) * kstep;
            const char* a3 = a2 + kstep; const char* b3 = b2 + kstep;
            if constexpr (Epi::HAS_MID) { if (t == nt / 2) E.mid(acc, wr, fr, ui, lds); }
            PG8_LDB(B0, 0, 0); PG8_LDB(B1, 0, 1); PG8_SCHED; PG8_LDA(At, 0, 0); PG8_STAGE(PG8_SA(1, 1), a1 + hstepA, voffA);
            PG8_WAIT_V(8); PG8_WAIT_L(0); PG8_BAR; PG8_MMA(0, 0, At, B0); PG8_MMA(0, 1, At, B1); PG8_BAR; PG8_SCHED;
            PG8_LDA(At, 0, 1); PG8_STAGE(PG8_SB(0, 0), b2, voffB); PG8_STAGE(PG8_SB(0, 1), b2 + hstepB, voffB); PG8_STAGE(PG8_SA(0, 0), a2, voffA);
            PG8_WAIT_V(8); PG8_WAIT_L(0); PG8_BAR; PG8_MMA(1, 0, At, B0); PG8_MMA(1, 1, At, B1); PG8_BAR; PG8_SCHED;
            PG8_LDB(B0, 1, 0); PG8_LDB(B1, 1, 1); PG8_SCHED; PG8_LDA(At, 1, 0); PG8_STAGE(PG8_SA(0, 1), a2 + hstepA, voffA);
            PG8_WAIT_V(8); PG8_WAIT_L(0); PG8_BAR; PG8_MMA(0, 0, At, B0); PG8_MMA(0, 1, At, B1); PG8_BAR; PG8_SCHED;
            PG8_LDA(At, 1, 1); PG8_STAGE(PG8_SB(1, 0), b3, voffB); PG8_STAGE(PG8_SB(1, 1), b3 + hstepB, voffB); PG8_STAGE(PG8_SA(1, 0), a3, voffA);
            PG8_WAIT_V(8); PG8_WAIT_L(0); PG8_BAR; PG8_MMA(1, 0, At, B0); PG8_MMA(1, 1, At, B1); PG8_BAR; PG8_SCHED;
        }
        if (wr == 0) PG8_BAR;
        E(acc, cur, wr, wc, fr, fq, ui, lds);
        if (!has_next) break;
#pragma unroll
        for (int a = 0; a < 2; ++a)
#pragma unroll
            for (int b = 0; b < 2; ++b)
#pragma unroll
                for (int m = 0; m < 4; ++m)
#pragma unroll
                    for (int n = 0; n < 2; ++n) acc[a][b][m][n] = (f32x4){0.f, 0.f, 0.f, 0.f};
        cur = nxt; cA = nA; cB = nB; ++ui;
        E.begin(cur, ui, tid, lds);
        if (wr == 1) PG8_BAR;
    }
    PG8_WAIT_V(0);
    PG8_BAR;
#undef PG8_SA
#undef PG8_SB
#undef PG8_STAGE
#undef PG8_LDA
#undef PG8_LDB
#undef PG8_MMA
#undef PG8_WAIT_V
#undef PG8_WAIT_L
#undef PG8_BAR
#undef PG8_SCHED
}
}

typedef const f32x4 (&AccRef)[2][2][4][2];

struct EpiP1 {
    static constexpr bool HAS_MID = false;
    P p;
    DEVI void begin(const pg8::Unit&, int, int, PG8_LAS unsigned char*) const {}
    DEVI void mid(f32x4 (&)[2][2][4][2], int, int, int, PG8_LAS unsigned char*) const {}
    DEVI void operator()(AccRef acc, const pg8::Unit& u, int wr, int wc, int fr, int fq, int, PG8_LAS unsigned char*) const {
        const float* rs = (const float*)(p.ws + W_RS);
        const int pn = u.pn;
        const int kind = pn < 2 ? 0 : (pn == 2 ? (wc < 2 ? 1 : 2) : (pn < 5 ? 3 : (pn < 7 ? 4 : 5)));
        float rs8[2][4];
#pragma unroll
        for (int ai = 0; ai < 2; ++ai)
#pragma unroll
            for (int m = 0; m < 4; ++m) rs8[ai][m] = rs[u.pm * 256 + ai * 128 + wr * 64 + m * 16 + fr];
        if (kind <= 1) {
            const float* nw = kind == 0 ? p.q_norm_w : p.k_norm_w;
            f32x4 w4[2][2];
#pragma unroll
            for (int bj = 0; bj < 2; ++bj)
#pragma unroll
                for (int n = 0; n < 2; ++n) w4[bj][n] = *(const f32x4*)(nw + 32 * bj + 8 * fq + 4 * n);
            const float2* rope = (const float2*)(p.ws + W_ROPE);
#pragma unroll
            for (int ai = 0; ai < 2; ++ai)
#pragma unroll
                for (int m = 0; m < 4; ++m) {
                    const int row = u.pm * 256 + ai * 128 + wr * 64 + m * 16 + fr;
                    const float rsv = rs8[ai][m];
                    const bool isp = row < NPR; const int b = row >= LP ? 1 : 0;
                    const int pos = isp ? row - b * LP : 8192 + ((row - NPR) & 7);
                    float v[2][2][4]; float ss = 0.f;
#pragma unroll
                    for (int bj = 0; bj < 2; ++bj)
#pragma unroll
                        for (int n = 0; n < 2; ++n)
#pragma unroll
                            for (int j = 0; j < 4; ++j) { v[bj][n][j] = acc[ai][bj][m][n][j] * rsv; ss += v[bj][n][j] * v[bj][n][j]; }
                    ss += __shfl_xor(ss, 16); ss += __shfl_xor(ss, 32);
                    const float rinv = rsqrtf(ss * (1.f / 64.f) + EPS);
                    const int rpos = pos < LP ? pos : LP - 1;
#pragma unroll
                    for (int n = 0; n < 2; ++n) {
                        const f32x4 cs0 = *(const f32x4*)(rope + (size_t)rpos * 32 + 8 * fq + 4 * n);
                        const f32x4 cs1 = *(const f32x4*)(rope + (size_t)rpos * 32 + 8 * fq + 4 * n + 2);
                        const float c[4] = {cs0[0], cs0[2], cs1[0], cs1[2]}, s[4] = {cs0[1], cs0[3], cs1[1], cs1[3]};
#pragma unroll
                        for (int j = 0; j < 4; ++j) { const float x1 = v[0][n][j] * rinv * w4[0][n][j], x2 = v[1][n][j] * rinv * w4[1][n][j];
                            v[0][n][j] = x1 * c[j] - x2 * s[j]; v[1][n][j] = x2 * c[j] + x1 * s[j]; }
                    }
                    if (kind == 0) {
                        if (row < NROWS) { bf16_t* qb = (bf16_t*)(p.ws + W_QB) + (size_t)row * 512 + (pn * 4 + wc) * 64 + 8 * fq;
#pragma unroll
                            for (int bj = 0; bj < 2; ++bj) { u32x4 w = {pk2(v[bj][0][0] * QSCALE, v[bj][0][1] * QSCALE), pk2(v[bj][0][2] * QSCALE, v[bj][0][3] * QSCALE), pk2(v[bj][1][0] * QSCALE, v[bj][1][1] * QSCALE), pk2(v[bj][1][2] * QSCALE, v[bj][1][3] * QSCALE)};
                                *(u32x4*)(qb + 32 * bj) = w; } }
                    } else {
                        const int kvh = wc;
                        if (row < NROWS) {
                            const int blk = isp ? b * 257 + (pos >> 5) : 514 + ((row - NPR) >> 3) * 5 + 4, key = isp ? (pos & 31) : ((row - NPR) & 7);
                            bf16_t* kF = (bf16_t*)(p.ws + W_KF);
#pragma unroll
                            for (int bj = 0; bj < 2; ++bj) { u32x4 w = {pk2(v[bj][0][0], v[bj][0][1]), pk2(v[bj][0][2], v[bj][0][3]), pk2(v[bj][1][0], v[bj][1][1]), pk2(v[bj][1][2], v[bj][1][3])};
                                *(u32x4*)(kF + ((size_t)((kvh * NBLK + blk) * 4 + 2 * bj + (fq >> 1)) * 64 + (fq & 1) * 32 + key) * 8) = w; }
                        }
                        if (isp) {
                            if (pos >= LP - 128) { float* o = p.out + O_KWP + ((size_t)(b * 128 + pos - (LP - 128)) * 2 + kvh) * 64 + 8 * fq;
#pragma unroll
                                for (int bj = 0; bj < 2; ++bj)
#pragma unroll
                                    for (int n = 0; n < 2; ++n) *(f32x4*)(o + 32 * bj + 4 * n) = (f32x4){v[bj][n][0], v[bj][n][1], v[bj][n][2], v[bj][n][3]}; }
                        } else if (row < NROWS) { float* o = p.out + O_KNS + ((size_t)(row - NPR) * 2 + kvh) * 64 + 8 * fq;
#pragma unroll
                            for (int bj = 0; bj < 2; ++bj)
#pragma unroll
                                for (int n = 0; n < 2; ++n) *(f32x4*)(o + 32 * bj + 4 * n) = (f32x4){v[bj][n][0], v[bj][n][1], v[bj][n][2], v[bj][n][3]}; }
                    }
                    asm volatile("" ::: "memory");
                }
        } else if (kind == 2) {
            const int kvh = wc - 2;
#pragma unroll
            for (int ai = 0; ai < 2; ++ai)
#pragma unroll
                for (int m = 0; m < 4; ++m) {
                    const int row = u.pm * 256 + ai * 128 + wr * 64 + m * 16 + fr;
                    const float rsv = rs8[ai][m];
                    const bool isp = row < NPR; const int b = row >= LP ? 1 : 0;
                    const int pos = isp ? row - b * LP : 0;
                    if (row < NROWS) {
                        const int blk = isp ? b * 257 + (pos >> 5) : 514 + ((row - NPR) >> 3) * 5 + 4, kk = isp ? (pos & 31) : ((row - NPR) & 7), s2 = kk >> 4, r16 = kk & 15, jj = (r16 >> 3) * 4 + (r16 & 3), hh = (r16 >> 2) & 1;
                        bf16_t* vF = (bf16_t*)(p.ws + W_VF);
#pragma unroll
                        for (int bj = 0; bj < 2; ++bj)
#pragma unroll
                            for (int n = 0; n < 2; ++n)
#pragma unroll
                                for (int j = 0; j < 4; ++j)
                                    vF[((size_t)(((kvh * NBLK + blk) * 2 + bj) * 2 + s2) * 64 + hh * 32 + (8 * fq + 4 * n + j)) * 8 + jj] = f2bf(acc[ai][bj][m][n][j] * rsv);
                    }
                    if (isp) {
                        if (pos >= LP - 128) { float* o = p.out + O_VWP + ((size_t)(b * 128 + pos - (LP - 128)) * 2 + kvh) * 64 + 8 * fq;
#pragma unroll
                            for (int bj = 0; bj < 2; ++bj)
#pragma unroll
                                for (int n = 0; n < 2; ++n) *(f32x4*)(o + 32 * bj + 4 * n) = acc[ai][bj][m][n] * rsv; }
                    } else if (row < NROWS) { float* o = p.out + O_VNS + ((size_t)(row - NPR) * 2 + kvh) * 64 + 8 * fq;
#pragma unroll
                        for (int bj = 0; bj < 2; ++bj)
#pragma unroll
                            for (int n = 0; n < 2; ++n) *(f32x4*)(o + 32 * bj + 4 * n) = acc[ai][bj][m][n] * rsv; }
                    asm volatile("" ::: "memory");
                }
        } else if (kind == 4) {
            bf16_t* uG = (bf16_t*)(p.ws + W_UG);
#pragma unroll
            for (int ai = 0; ai < 2; ++ai)
#pragma unroll
                for (int m = 0; m < 4; ++m) {
                    const int row = u.pm * 256 + ai * 128 + wr * 64 + m * 16 + fr;
                    const float rsv = rs8[ai][m];
                    if (row < NROWS) {
#pragma unroll
                        for (int bj = 0; bj < 2; ++bj) { const int g = (pn - 5) * 16 + 4 * wc + 2 * bj + (fq >> 1); const f32x4 t0 = acc[ai][bj][m][0] * rsv, t1 = acc[ai][bj][m][1] * rsv;
                            u32x4 w = {pk2(t0[0], t0[1]), pk2(t0[2], t0[3]), pk2(t1[0], t1[1]), pk2(t1[2], t1[3])}; *(u32x4*)(uG + ((size_t)g * NROWS_PAD + row) * 16 + 8 * (fq & 1)) = w; }
                    }
                }
        } else {
            bf16_t* dst0 = (bf16_t*)(p.ws + (kind == 3 ? W_GA : W_GS)) + (kind == 3 ? pn - 3 : pn - 7) * 256 + 64 * wc + 8 * fq;
#pragma unroll
            for (int ai = 0; ai < 2; ++ai)
#pragma unroll
                for (int m = 0; m < 4; ++m) {
                    const int row = u.pm * 256 + ai * 128 + wr * 64 + m * 16 + fr;
                    const float rsv = rs8[ai][m];
                    if (row < NROWS) {
                        const int rowd = kind == 3 ? row : row3_of(row);
#pragma unroll
                        for (int bj = 0; bj < 2; ++bj) { const f32x4 t0 = acc[ai][bj][m][0] * rsv, t1 = acc[ai][bj][m][1] * rsv;
                            u32x4 w = {pk2(t0[0], t0[1]), pk2(t0[2], t0[3]), pk2(t1[0], t1[1]), pk2(t1[2], t1[3])}; *(u32x4*)(dst0 + (size_t)rowd * 512 + 32 * bj) = w; }
                    }
                }
        }
    }
};

struct EpiGlu {
    static constexpr bool HAS_MID = false;
    P p;
    DEVI void begin(const pg8::Unit&, int, int, PG8_LAS unsigned char*) const {}
    DEVI void mid(f32x4 (&)[2][2][4][2], int, int, int, PG8_LAS unsigned char*) const {}
    DEVI void operator()(AccRef acc, const pg8::Unit& u, int wr, int wc, int fr, int fq, int, PG8_LAS unsigned char*) const {
        const bf16_t* gB = gb_base(p.ws, u.pm >= 64); const bf16_t* gs = (const bf16_t*)(p.ws + W_GS);
        bf16_t* cat = (bf16_t*)(p.ws + W_CAT); float* ssqs = (float*)(p.ws + W_SSQS);
        const int f0 = u.pn * 256 + 32 * wc + 8 * fq;
        f32x4 bg[2][2];
#pragma unroll
        for (int bj = 0; bj < 2; ++bj)
#pragma unroll
            for (int n = 0; n < 2; ++n) bg[bj][n] = *(const f32x4*)(p.b_glu + f0 + 128 * bj + 4 * n);
#pragma unroll
        for (int ai = 0; ai < 2; ++ai)
#pragma unroll
            for (int m = 0; m < 4; ++m) {
                const int row = u.pm * 256 + ai * 128 + wr * 64 + m * 16 + fr;
                float ssq = 0.f;
#pragma unroll
                for (int bj = 0; bj < 2; ++bj) {
                    const int f = f0 + 128 * bj;
                    const u32x4 gw = *(const u32x4*)(gB + (size_t)row * 512 + f), sw = *(const u32x4*)(gs + (size_t)row * 512 + f);
                    float s[8];
#pragma unroll
                    for (int n = 0; n < 2; ++n)
#pragma unroll
                        for (int j = 0; j < 4; ++j) { const unsigned gwd = gw[2 * n + (j >> 1)], swd = sw[2 * n + (j >> 1)];
                            const float gl = (j & 1) ? bfhi(gwd) : bflo(gwd), gv = (j & 1) ? bfhi(swd) : bflo(swd);
                            s[4 * n + j] = gl * sigmoid_f(acc[ai][bj][m][n][j] + bg[bj][n][j]) * silu_f(gv); ssq += s[4 * n + j] * s[4 * n + j]; }
                    { u32x4 w = {pk2(s[0], s[1]), pk2(s[2], s[3]), pk2(s[4], s[5]), pk2(s[6], s[7])}; *(u32x4*)(cat + (size_t)row * 1024 + 512 + f) = w; }
                }
                ssq += __shfl_xor(ssq, 16); ssq += __shfl_xor(ssq, 32);
                if (fq == 0) ssqs[(size_t)row * 8 + u.pn * 4 + wc] = ssq;
                asm volatile("" ::: "memory");
            }
    }
};

constexpr int LDS_TAB = 131072;
struct EpiOut {
    static constexpr bool HAS_MID = true;
    P p;
    DEVI void begin(const pg8::Unit& u, int ui, int tid, PG8_LAS unsigned char* lds) const {
        if (tid < 256) {
            const int row = u.pm * 256 + tid;
            float ra = 1.f, rsv = 1.f;
            {
                const float* ssqa = (const float*)(p.ws + W_SSQA) + (size_t)row * 8; const float* ssqs = (const float*)(p.ws + W_SSQS) + (size_t)row * 8;
                const f32x4 a0 = *(const f32x4*)(ssqa), a1 = *(const f32x4*)(ssqa + 4), s0 = *(const f32x4*)(ssqs), s1 = *(const f32x4*)(ssqs + 4);
                ra = rsqrtf(((a0[0] + a0[1]) + (a0[2] + a0[3]) + (a1[0] + a1[1]) + (a1[2] + a1[3])) * (1.f / 512.f) + EPS);
                rsv = rsqrtf(((s0[0] + s0[1]) + (s0[2] + s0[3]) + (s1[0] + s1[1]) + (s1[2] + s1[3])) * (1.f / 512.f) + EPS);
            }
            ((PG8_LAS f32x2*)(lds + LDS_TAB))[(ui & 1) * 256 + tid] = (f32x2){ra / rsv, rsv};
        }
    }
    DEVI void mid(f32x4 (&acc)[2][2][4][2], int wr, int fr, int ui, PG8_LAS unsigned char* lds) const {
#pragma unroll
        for (int ai = 0; ai < 2; ++ai)
#pragma unroll
            for (int m = 0; m < 4; ++m) {
                const float sc = ((const PG8_LAS f32x2*)(lds + LDS_TAB))[(ui & 1) * 256 + ai * 128 + wr * 64 + m * 16 + fr].x;
#pragma unroll
                for (int bj = 0; bj < 2; ++bj)
#pragma unroll
                    for (int n = 0; n < 2; ++n) acc[ai][bj][m][n] *= sc;
            }
    }
    DEVI void operator()(AccRef acc, const pg8::Unit& u, int wr, int wc, int fr, int fq, int ui, PG8_LAS unsigned char* lds) const {
#pragma unroll
        for (int ai = 0; ai < 2; ++ai) {
            f32x4 xv[4][2][2]; size_t off[4]; float rsv[4];
#pragma unroll
            for (int m = 0; m < 4; ++m) {
                const int rl = ai * 128 + wr * 64 + m * 16 + fr, row = u.pm * 256 + rl;
                rsv[m] = ((const PG8_LAS f32x2*)(lds + LDS_TAB))[(ui & 1) * 256 + rl].y;
                const float* xr;
                if (row < 16384) { off[m] = (size_t)row * 1024 + O_YP; xr = p.x_prompt + (size_t)row * 1024; }
                else { off[m] = (size_t)(row - 16384) * 1024 + O_YS; xr = p.x_sample + (size_t)(row - 16384) * 1024; }
#pragma unroll
                for (int bj = 0; bj < 2; ++bj)
#pragma unroll
                    for (int n = 0; n < 2; ++n) xv[m][bj][n] = *(const f32x4*)(xr + u.pn * 256 + 128 * bj + 32 * wc + 8 * fq + 4 * n);
            }
#pragma unroll
            for (int m = 0; m < 4; ++m) {
                float* yo = p.out + off[m];
#pragma unroll
                for (int bj = 0; bj < 2; ++bj)
#pragma unroll
                    for (int n = 0; n < 2; ++n) *(f32x4*)(yo + u.pn * 256 + 128 * bj + 32 * wc + 8 * fq + 4 * n) = xv[m][bj][n] + acc[ai][bj][m][n] * rsv[m];
            }
            asm volatile("" ::: "memory");
        }
    }
};

DEVI void phase1(const P& p, PG8_LAS unsigned char* lds) {
    pg8::Gemm g{(const bf16_t*)(p.ws + W_XB), (const bf16_t*)(p.ws + W_WINT), 1024, 1024, 1024};
    pg8::StaticOrder S; S.init(NROWS_PAD, 2304, gridDim.x, blockIdx.x);
    EpiP1 E{p};
    pg8::gemm_phase<EpiP1, pg8::StaticOrder>(lds, g, S, E);
    const int n3 = 621 - 2 * (int)gridDim.x;
    if ((int)blockIdx.x >= n3) deferred_prep(p, ((int)blockIdx.x - n3) * 512 + tidx(), ((int)gridDim.x - n3) * 512);
}
template <bool FIRST>
struct EpiOutHalf {
    static constexpr bool HAS_MID = false;
    P p;
    DEVI void begin(const pg8::Unit& u, int ui, int tid, PG8_LAS unsigned char* lds) const {
        if (tid < 256) {
            const int row = u.pm * 256 + tid;
            const float* ssq = (const float*)(p.ws + (FIRST ? W_SSQA : W_SSQS)) + (size_t)row * 8;
            const f32x4 a0 = *(const f32x4*)(ssq), a1 = *(const f32x4*)(ssq + 4);
            ((PG8_LAS float*)(lds + LDS_TAB))[(ui & 1) * 256 + tid] = rsqrtf(((a0[0] + a0[1]) + (a0[2] + a0[3]) + (a1[0] + a1[1]) + (a1[2] + a1[3])) * (1.f / 512.f) + EPS);
        }
    }
    DEVI void mid(f32x4 (&)[2][2][4][2], int, int, int, PG8_LAS unsigned char*) const {}
    DEVI void operator()(AccRef acc, const pg8::Unit& u, int wr, int wc, int fr, int fq, int ui, PG8_LAS unsigned char* lds) const {
#pragma unroll
        for (int ai = 0; ai < 2; ++ai)
#pragma unroll
            for (int m = 0; m < 4; ++m) {
                const int rl = ai * 128 + wr * 64 + m * 16 + fr, row = u.pm * 256 + rl;
                const float rsv = ((const PG8_LAS float*)(lds + LDS_TAB))[(ui & 1) * 256 + rl];
                const size_t o = (size_t)(row - 16384) * 1024; const float* xr = p.x_sample + o; float* yo = p.out + O_YS + o;
#pragma unroll
                for (int bj = 0; bj < 2; ++bj)
#pragma unroll
                    for (int n = 0; n < 2; ++n) { const int f = u.pn * 256 + 128 * bj + 32 * wc + 8 * fq + 4 * n;
                        const f32x4 base = FIRST ? *(const f32x4*)(xr + f) : *(const f32x4*)(yo + f); *(f32x4*)(yo + f) = base + acc[ai][bj][m][n] * rsv; }
                asm volatile("" ::: "memory");
            }
    }
};
struct SchedOne { int pm, pn; DEVI bool next(int i, pg8::Unit& u) const { if (i != 0) return false; u.pm = pm; u.pn = pn; return true; } };
DEVI void glu_unit(const P& p, PG8_LAS unsigned char* lds, int pm, int pn) {
    pg8::Gemm g{gb_base(p.ws, pm >= 64), (const bf16_t*)(p.ws + W_WGLUT), 512, 512, 512}; SchedOne S{pm, pn}; EpiGlu E{p};
    pg8::gemm_phase<EpiGlu, SchedOne>(lds, g, S, E);
}
DEVI void out_unit(const P& p, PG8_LAS unsigned char* lds, int pm, int pn) {
    pg8::Gemm g{(const bf16_t*)(p.ws + W_CAT), (const bf16_t*)(p.ws + W_WOUTT), 1024, 1024, 1024}; SchedOne S{pm, pn}; EpiOut E{p};
    pg8::gemm_phase<EpiOut, SchedOne>(lds, g, S, E);
}
template <bool FIRST>
DEVI void out_half_unit(const P& p, PG8_LAS unsigned char* lds, int pm, int pn) {
    pg8::Gemm g{(const bf16_t*)(p.ws + W_CAT) + (FIRST ? 0 : 512), (const bf16_t*)(p.ws + W_WOUTT) + (FIRST ? 0 : 512), 1024, 1024, 512}; SchedOne S{pm, pn}; EpiOutHalf<FIRST> E{p};
    pg8::gemm_phase<EpiOutHalf<FIRST>, SchedOne>(lds, g, S, E);
}
DEVI void phase2b_gemm(const P& p, PG8_LAS unsigned char* lds) {
    const int c = blockIdx.x;
    if (c >= 248) glu_unit(p, lds, 64 + ((c - 248) >> 1), (c - 248) & 1);
    else out_half_unit<true>(p, lds, 64 + ((c - 232) >> 2), (c - 232) & 3);
}
DEVI void phase3a(const P& p, PG8_LAS unsigned char* lds) {
    const int c = blockIdx.x;
    if (c < 128) { const int x = c & 7, s = c >> 3; glu_unit(p, lds, x * 8 + (s >> 1), s & 1); }
    else if (c < 144) out_half_unit<false>(p, lds, 64 + ((c - 128) >> 2), (c - 128) & 3);
}
DEVI void phase3b(const P& p, PG8_LAS unsigned char* lds) { const int c = blockIdx.x, x = c & 7, s = c >> 3; out_unit(p, lds, x * 8 + (s >> 2), s & 3); }

__global__ void __launch_bounds__(512, 2) hymba_fwd(P p) {
    extern __shared__ __attribute__((aligned(16))) unsigned char lds_dyn[];
    PG8_LAS unsigned char* lds = (PG8_LAS unsigned char*)lds_dyn;
    if (threadIdx.x < 16) ((PG8_LAS unsigned*)(lds + LDS_XB))[threadIdx.x] = 0u;
    __syncthreads();
    XcdBarrier xb = xcd_barrier_post((unsigned*)(p.ws + W_BAR), (volatile LAS unsigned*)(lds + LDS_XB));
#ifndef REP0
#define REP0 1
#define REP1 1
#define REP2A 1
#define REP2B 1
#define REP3A 1
#define REP3B 1
#endif
    for (int r = 0; r < REP0; ++r) { phase0(p); xcd_barrier(xb); }
    for (int r = 0; r < REP1; ++r) { phase1(p, lds); xcd_barrier(xb); }
    for (int r = 0; r < REP2A; ++r) { phase2a(p, (char*)lds_dyn); xcd_barrier(xb); }
    if (blockIdx.x < 232) phase2b(p, (char*)lds_dyn); else phase2b_gemm(p, lds);
    xcd_barrier(xb);
    for (int r = 0; r < REP3A; ++r) { phase3a(p, lds); xcd_barrier(xb); }
    for (int r = 0; r < REP3B; ++r) { phase3b(p, lds); if (r + 1 < REP3B) xcd_barrier(xb); }
}

extern "C" void kernel_launch(void* const* d_in, const int* in_sizes, int n_in, void* d_out, int out_size, void* d_ws, size_t ws_size, hipStream_t stream) {
    P p{};
    const float** pp = (const float**)&p;
    for (int i = 0; i < 25; ++i) pp[i] = (const float*)d_in[i];
    p.out = (float*)d_out; p.ws = (char*)d_ws;
    static int grid_blocks = 0;
    if (!grid_blocks) {
        int dev = 0, cus = 0, per_cu = 0;
        (void)hipGetDevice(&dev);
        (void)hipDeviceGetAttribute(&cus, hipDeviceAttributeMultiprocessorCount, dev);
        (void)hipFuncSetAttribute((const void*)hymba_fwd, hipFuncAttributeMaxDynamicSharedMemorySize, LDS_BYTES);
        (void)hipOccupancyMaxActiveBlocksPerMultiprocessor(&per_cu, hymba_fwd, 512, LDS_BYTES);
        if (per_cu < 1) fprintf(stderr, "occupancy query reports %d blocks per CU\n", per_cu);
        grid_blocks = cus;
    }
    (void)hipMemsetAsync((char*)d_ws + W_BAR, 0, 16384, stream);
    void* args[] = {&p};
    hipError_t e = hipLaunchCooperativeKernel((void*)hymba_fwd, dim3(grid_blocks), dim3(512), args, LDS_BYTES, stream);
    if (e != hipSuccess) fprintf(stderr, "cooperative launch failed: %s (grid %d)\n", hipGetErrorString(e), grid_blocks);
}
```

```cpp
#include <hip/hip_runtime.h>
#include <hip/hip_cooperative_groups.h>
#include <cstdio>
#include <cstdint>
namespace cg = cooperative_groups;

#ifndef SINGLE_LAUNCH
#define SINGLE_LAUNCH 1
#endif

#define DEVI __device__ __forceinline__
typedef unsigned short bf16_t;
typedef short bf16x8 __attribute__((ext_vector_type(8)));
typedef float f32x4 __attribute__((ext_vector_type(4)));
typedef float f32x16 __attribute__((ext_vector_type(16)));
typedef unsigned u32x2 __attribute__((ext_vector_type(2)));
typedef float f32x2 __attribute__((ext_vector_type(2)));
typedef unsigned u32x4 __attribute__((ext_vector_type(4)));

constexpr int LP = 8208;
constexpr int NPR = 2 * LP;
constexpr int NROWS = NPR + 1024;
constexpr int NROWS_PAD = 17664;
constexpr int NBLK = 514 + 640;
constexpr float EPS = 1e-6f;
constexpr float LOG2E = 1.4426950408889634f;
constexpr float QSCALE = 0.125f * LOG2E;

constexpr size_t O_YP = 0, O_YS = 16777216, O_KWP = 17825792, O_VWP = 17858560, O_SRP = 17891328, O_SIP = 17895424,
                 O_KNS = 17899520, O_VNS = 18030592, O_SRS = 18161664, O_SIS = 18423808;

constexpr size_t al256(size_t x) { return (x + 255) & ~(size_t)255; }
constexpr size_t W_BAR = 0;
constexpr size_t W_XB = 16384;
constexpr size_t W_RS = al256(W_XB + (size_t)NROWS_PAD * 1024 * 2);
constexpr size_t W_WINT = al256(W_RS + (size_t)NROWS_PAD * 4);
constexpr size_t W_WGLUT = al256(W_WINT + (size_t)2304 * 1024 * 2);
constexpr size_t W_WOUTT = al256(W_WGLUT + (size_t)512 * 512 * 2);
constexpr size_t W_ROPE = al256(W_WOUTT + (size_t)1024 * 1024 * 2);
constexpr size_t W_LAM = al256(W_ROPE + (size_t)LP * 32 * 8);
constexpr size_t W_LAM64 = al256(W_LAM + 32 * 64 * 8);
constexpr size_t W_BBARF = al256(W_LAM64 + 32 * 64 * 8);
constexpr size_t W_CMF = al256(W_BBARF + 32 * 4 * 64 * 8 * 2);
constexpr size_t W_QB = al256(W_CMF + 32 * 4 * 64 * 8 * 2);
constexpr size_t W_KF = al256(W_QB + (size_t)NROWS_PAD * 512 * 2);
constexpr size_t W_VF = al256(W_KF + (size_t)2 * NBLK * 4 * 64 * 8 * 2);
constexpr size_t W_GA = al256(W_VF + (size_t)2 * NBLK * 4 * 64 * 8 * 2);
constexpr size_t W_GS = al256(W_GA + (size_t)NROWS_PAD * 512 * 2);
constexpr size_t W_UG = al256(W_GS + (size_t)NROWS_PAD * 512 * 2);
constexpr size_t W_CAT = W_XB;
constexpr size_t W_SSQA = al256(W_UG + (size_t)NROWS_PAD * 512 * 2);
constexpr size_t W_GB = W_QB;
constexpr size_t W_GBS = al256(W_SSQA + (size_t)NROWS_PAD * 8 * 4);
constexpr size_t W_SSQS = al256(W_GBS + (size_t)1024 * 512 * 2);
DEVI bf16_t* gb_base(char* ws, bool sample_rows) { return sample_rows ? (bf16_t*)(ws + W_GBS) - (size_t)16384 * 512 : (bf16_t*)(ws + W_GB); }
constexpr size_t W_ENDS = al256(W_SSQS + (size_t)NROWS_PAD * 8 * 4);
constexpr size_t W_CARRY = al256(W_ENDS + (size_t)2 * 32 * 128 * 64 * 8);
constexpr size_t W_TOTAL = al256(W_CARRY + (size_t)2 * 32 * 129 * 64 * 8);

constexpr int LDS_XB = 131072 + 4096;
constexpr int LDS_BYTES = LDS_XB + 64;

struct P {
    const float *x_prompt, *x_sample, *cache_k, *cache_v, *st_re, *st_im, *meta, *norm_w, *w_in, *q_norm_w, *k_norm_w, *sinks,
        *aon_w, *A_re, *A_im, *log_dt, *B_re, *B_im, *C_re, *C_im, *Dk, *w_glu, *b_glu, *son_w, *w_out;
    float* out;
    char* ws;
};

DEVI int tidx() { int t = threadIdx.x; asm volatile("" : "+v"(t)); return t; }
constexpr int NROWS3 = 17408;
DEVI int row3_of(int row) {
    if (row >= NPR) return 16384 + (row - NPR);
    const int b = row >= LP ? 1 : 0, pos = row - b * LP;
    return pos >= 16 ? b * 8192 + pos - 16 : NROWS3 + b * 16 + pos;
}
typedef __bf16 bf16x2_t __attribute__((ext_vector_type(2)));
DEVI unsigned pk2(float lo, float hi) { const f32x2 v = {lo, hi}; const bf16x2_t b = __builtin_convertvector(v, bf16x2_t); return __builtin_bit_cast(unsigned, b); }
DEVI bf16_t f2bf(float f) { return (bf16_t)(pk2(f, 0.f) & 0xffffu); }
DEVI float bf2f(unsigned short b) { return __uint_as_float(((unsigned)b) << 16); }
DEVI float bflo(unsigned w) { return __uint_as_float(w << 16); }
DEVI float bfhi(unsigned w) { return __uint_as_float(w & 0xffff0000u); }
DEVI float silu_f(float x) { return x * __builtin_amdgcn_rcpf(1.f + __expf(-x)); }
DEVI float sigmoid_f(float x) { return __builtin_amdgcn_rcpf(1.f + __expf(-x)); }
DEVI float gelu_tanh(float x) {
    const float u = 1.5957691216057308f * (x + 0.044715f * x * x * x);
    return x * __builtin_amdgcn_rcpf(1.f + __expf(-u));
}
DEVI f32x4 mfma16(bf16x8 a, bf16x8 b, f32x4 c) { return __builtin_amdgcn_mfma_f32_16x16x32_bf16(a, b, c, 0, 0, 0); }
DEVI f32x16 mfma32(bf16x8 a, bf16x8 b, f32x16 c) { return __builtin_amdgcn_mfma_f32_32x32x16_bf16(a, b, c, 0, 0, 0); }
DEVI bf16x8 mk8(unsigned a, unsigned b, unsigned c, unsigned d) { u32x4 t = {a, b, c, d}; return __builtin_bit_cast(bf16x8, t); }


#define XB_TMO      128
#define XB_XCNT(j)  (256  + 64 * (j))
#define XB_XSUB(j)  (1280 + 64 * (j))
#define XB_XGEN(j)  (2304 + 64 * (j))
#define XB_TOP      3328
#define XB_TOPGEN   3392
#define XCD_BAR_WORDS 3456
#define XB_SPIN_CAP (1u << 18)
#define LAS __attribute__((address_space(3)))
DEVI unsigned xb_ld(unsigned* p) { return __hip_atomic_load(p, __ATOMIC_RELAXED, __HIP_MEMORY_SCOPE_AGENT); }
DEVI unsigned xb_add(unsigned* p, unsigned v) { return __hip_atomic_fetch_add(p, v, __ATOMIC_RELAXED, __HIP_MEMORY_SCOPE_AGENT); }
DEVI unsigned xb_xcc_id() { return (unsigned)__builtin_amdgcn_s_getreg((3 << 11) | 20) & 0xFu; }
#define XB_SPIN(cond, bar) do { unsigned _sp = 0; while (cond) { __builtin_amdgcn_s_sleep(1); \
    if ((++_sp & 255u) == 0u) { if (xb_ld(&(bar)[XB_TMO])) break; if (_sp > XB_SPIN_CAP) { atomicAdd(&(bar)[XB_TMO], 1u); break; } } } } while (0)
struct XcdBarrier { unsigned* bar; unsigned x; volatile LAS unsigned* st; };
DEVI XcdBarrier xcd_barrier_post(unsigned* bar, volatile LAS unsigned* st) {
    XcdBarrier b; b.bar = bar; b.x = xb_xcc_id(); b.st = st;
    if (tidx() == 0) (void)xb_add(&bar[XB_XCNT(b.x)], 1u);
    return b;
}
DEVI void xcd_barrier_complete(unsigned* bar, unsigned x, unsigned& nloc, unsigned& nx) {
    const unsigned G = gridDim.x * gridDim.y * gridDim.z;
    unsigned sum, cnt, mine, sp = 0u;
    for (;;) {
        sum = 0u; cnt = 0u; mine = 0u;
#pragma unroll
        for (unsigned j = 0; j < 16; ++j) { const unsigned c = xb_ld(&bar[XB_XCNT(j)]); sum += c; cnt += (c > 0u) ? 1u : 0u; mine = (j == x) ? c : mine; }
        if (sum == G) break;
        __builtin_amdgcn_s_sleep(1);
        if ((++sp & 255u) == 0u) { if (xb_ld(&bar[XB_TMO])) break; if (sp > XB_SPIN_CAP) { atomicAdd(&bar[XB_TMO], 1u); break; } }
    }
    nloc = mine > 0u ? mine : 1u; nx = cnt > 0u ? cnt : 1u;
}
DEVI void xcd_barrier(const XcdBarrier& b) {
    asm volatile("s_waitcnt vmcnt(0)" ::: "memory");
    __syncthreads();
    if (tidx() == 0) {
        unsigned* bar = b.bar;
        __builtin_amdgcn_s_waitcnt(0);
        unsigned nloc = b.st[0], nx = b.st[1];
        if (nloc == 0u) { xcd_barrier_complete(bar, b.x, nloc, nx); b.st[0] = nloc; b.st[1] = nx; }
        const unsigned old = xb_add(&bar[XB_XSUB(b.x)], 1u);
        const unsigned gen = old / nloc;
        if (old + 1u == (gen + 1u) * nloc) {
            __builtin_amdgcn_fence(__ATOMIC_RELEASE, "agent");
            asm volatile("s_waitcnt vmcnt(0)" ::: "memory");
            const unsigned og = xb_add(&bar[XB_TOP], 1u);
            const unsigned tg = og / nx;
            if (og + 1u == (tg + 1u) * nx) xb_add(&bar[XB_TOPGEN], 1u);
            else XB_SPIN(xb_ld(&bar[XB_TOPGEN]) == tg, bar);
            __builtin_amdgcn_fence(__ATOMIC_ACQUIRE, "agent");
            xb_add(&bar[XB_XGEN(b.x)], 1u);
            asm volatile("s_waitcnt vmcnt(0)" ::: "memory");
        } else {
            XB_SPIN(xb_ld(&bar[XB_XGEN(b.x)]) == gen, bar);
            __builtin_amdgcn_fence(__ATOMIC_ACQUIRE, "agent");
            asm volatile("s_waitcnt vmcnt(0)" ::: "memory");
        }
    }
    __syncthreads();
}

DEVI const float* row_src(const P& p, int r) {
    if (r < NPR) { const int b = r >= LP ? 1 : 0, pos = r - b * LP; return pos < 16 ? p.meta + (size_t)pos * 1024 : p.x_prompt + ((size_t)b * 8192 + pos - 16) * 1024; }
    if (r < NROWS) return p.x_sample + (size_t)(r - NPR) * 1024;
    return nullptr;
}

DEVI void p0_ssm_f(const P& p, int i, float& fre, float& fim, float2& lamv, float2& lam64v) {
    const int g = i >> 6;
    const double dt = exp((double)p.log_dt[g]), are = p.A_re[i], aim = p.A_im[i];
    const double mag = exp(dt * are);
    double th = dt * aim * 0.15915494309189535; th -= rint(th); th *= 6.283185307179586;
    const float thf = (float)th; const float sh = sinf(0.5f * thf);
    const double lr = mag * (double)cosf(thf), li = mag * (double)sinf(thf);
    const double lrm1 = expm1(dt * are) - mag * 2.0 * (double)sh * (double)sh;
    lamv = make_float2((float)lr, (float)li);
    const double mag64 = exp(64.0 * dt * are);
    double th64 = 64.0 * dt * aim * 0.15915494309189535; th64 -= rint(th64); th64 *= 6.283185307179586;
    lam64v = make_float2((float)(mag64 * (double)cosf((float)th64)), (float)(mag64 * (double)sinf((float)th64)));
    const double den = are * are + aim * aim;
    fre = (float)((lrm1 * are + li * aim) / den); fim = (float)((li * are - lrm1 * aim) / den);
}

DEVI void phase0(const P& p) {
    const int gtid = blockIdx.x * 512 + tidx(), gsz = gridDim.x * 512;
    const int gw = gtid >> 6, nw = gsz >> 6, lane = tidx() & 63;
    bf16_t* xb = (bf16_t*)(p.ws + W_XB); float* rs = (float*)(p.ws + W_RS);
    for (int r = gw * 2; r < NROWS_PAD; r += nw * 2) {
        const float* src0 = row_src(p, r); const float* src1 = row_src(p, r + 1);
        f32x4 v[2][4]; float ss0 = 0.f, ss1 = 0.f;
#pragma unroll
        for (int i = 0; i < 4; ++i) {
            v[0][i] = src0 ? *(const f32x4*)(src0 + (i * 64 + lane) * 4) : (f32x4){0.f, 0.f, 0.f, 0.f};
            v[1][i] = src1 ? *(const f32x4*)(src1 + (i * 64 + lane) * 4) : (f32x4){0.f, 0.f, 0.f, 0.f};
        }
#pragma unroll
        for (int i = 0; i < 4; ++i) {
            ss0 += v[0][i][0] * v[0][i][0] + v[0][i][1] * v[0][i][1] + v[0][i][2] * v[0][i][2] + v[0][i][3] * v[0][i][3];
            ss1 += v[1][i][0] * v[1][i][0] + v[1][i][1] * v[1][i][1] + v[1][i][2] * v[1][i][2] + v[1][i][3] * v[1][i][3];
        }
#pragma unroll
        for (int o = 32; o >= 1; o >>= 1) { ss0 += __shfl_xor(ss0, o); ss1 += __shfl_xor(ss1, o); }
        if (lane == 0) { rs[r] = rsqrtf(ss0 * (1.f / 1024.f) + EPS); rs[r + 1] = rsqrtf(ss1 * (1.f / 1024.f) + EPS); }
#pragma unroll
        for (int i = 0; i < 4; ++i) {
            u32x2 w0 = {pk2(v[0][i][0], v[0][i][1]), pk2(v[0][i][2], v[0][i][3])}; *(u32x2*)(xb + (size_t)r * 1024 + (i * 64 + lane) * 4) = w0;
            u32x2 w1 = {pk2(v[1][i][0], v[1][i][1]), pk2(v[1][i][2], v[1][i][3])}; *(u32x2*)(xb + (size_t)(r + 1) * 1024 + (i * 64 + lane) * 4) = w1;
        }
    }
    bf16_t* winT = (bf16_t*)(p.ws + W_WINT);
    for (int i = gtid; i < 2304 * 128; i += gsz) {
        const int n = i % 2304, k8 = i / 2304; float t[8];
        const int f = (n & ~255) + ((n >> 5) & 3) * 64 + ((n >> 7) & 1) * 32 + (n & 31);
#pragma unroll
        for (int j = 0; j < 8; ++j) t[j] = p.w_in[(size_t)(k8 * 8 + j) * 2304 + f] * p.norm_w[k8 * 8 + j];
        u32x4 w = {pk2(t[0], t[1]), pk2(t[2], t[3]), pk2(t[4], t[5]), pk2(t[6], t[7])};
        *(u32x4*)(winT + (size_t)n * 1024 + k8 * 8) = w;
    }
    {
        bf16_t* kF = (bf16_t*)(p.ws + W_KF); bf16_t* vF = (bf16_t*)(p.ws + W_VF);
        for (int i = gtid; i < 2 * 130 * 256; i += gsz) {
            const int piece = i & 255, s = (i >> 8) % 130, kvh = (i >> 8) / 130;
            const int blk = s < 2 ? s * 257 + 256 : 514 + (s - 2) * 5 + 4;
            const u32x4 z = {0u, 0u, 0u, 0u};
            *(u32x4*)(kF + (size_t)(kvh * NBLK + blk) * 2048 + piece * 8) = z;
            *(u32x4*)(vF + (size_t)(kvh * NBLK + blk) * 2048 + piece * 8) = z;
        }
    }
    float2* rope = (float2*)(p.ws + W_ROPE);
    for (int i = gtid; i < LP * 32; i += gsz) {
        const int pos = i >> 5, d = i & 31;
        const double inv = exp2(-(double)d * (13.287712379549449 / 32.0));
        double t = (double)pos * inv * 0.15915494309189535; t -= rint(t);
        const float r = (float)(t * 6.283185307179586);
        rope[i] = make_float2(cosf(r), sinf(r));
    }
}

DEVI void deferred_prep(const P& p, int gtid, int gsz) {
    bf16_t* wgT = (bf16_t*)(p.ws + W_WGLUT);
    for (int i = gtid; i < 512 * 64; i += gsz) {
        const int n = i % 512, k8 = i / 512; float t[8];
#pragma unroll
        for (int j = 0; j < 8; ++j) t[j] = p.w_glu[(size_t)(k8 * 8 + j) * 512 + n];
        u32x4 w = {pk2(t[0], t[1]), pk2(t[2], t[3]), pk2(t[4], t[5]), pk2(t[6], t[7])};
        *(u32x4*)(wgT + (size_t)n * 512 + k8 * 8) = w;
    }
    bf16_t* woT = (bf16_t*)(p.ws + W_WOUTT);
    for (int i = gtid; i < 1024 * 128; i += gsz) {
        const int n = i % 1024, k8 = i / 1024; float t[8];
#pragma unroll
        for (int j = 0; j < 8; ++j) { const int k = k8 * 8 + j; t[j] = p.w_out[(size_t)k * 1024 + n] * (k < 512 ? p.aon_w[k] : p.son_w[k - 512]); }
        u32x4 w = {pk2(t[0], t[1]), pk2(t[2], t[3]), pk2(t[4], t[5]), pk2(t[6], t[7])};
        *(u32x4*)(woT + (size_t)n * 1024 + k8 * 8) = w;
    }
    {
        bf16_t* kF = (bf16_t*)(p.ws + W_KF); bf16_t* vF = (bf16_t*)(p.ws + W_VF);
        for (int i = gtid; i < 2 * 128 * 4 * 4 * 64; i += gsz) {
            const int ln = i & 63, ks = (i >> 6) & 3, kb = (i >> 8) & 3, db = (i >> 10) & 127, kvh = i >> 17;
            const float* kp = p.cache_k + ((size_t)(db * 128 + kb * 32 + (ln & 31)) * 2 + kvh) * 64 + ks * 16 + (ln >> 5) * 8;
            const f32x4 a = *(const f32x4*)kp, c = *(const f32x4*)(kp + 4);
            u32x4 w = {pk2(a[0], a[1]), pk2(a[2], a[3]), pk2(c[0], c[1]), pk2(c[2], c[3])};
            *(u32x4*)(kF + ((size_t)((kvh * NBLK + 514 + db * 5 + kb) * 4 + ks) * 64 + ln) * 8) = w;
            const int db2 = ks >> 1, s2 = ks & 1, h = ln >> 5; float t[8];
#pragma unroll
            for (int j = 0; j < 8; ++j) { const int key = 16 * s2 + 8 * (j >> 2) + 4 * h + (j & 3);
                t[j] = p.cache_v[((size_t)(db * 128 + kb * 32 + key) * 2 + kvh) * 64 + db2 * 32 + (ln & 31)]; }
            u32x4 wv = {pk2(t[0], t[1]), pk2(t[2], t[3]), pk2(t[4], t[5]), pk2(t[6], t[7])};
            *(u32x4*)(vF + ((size_t)(((kvh * NBLK + 514 + db * 5 + kb) * 2 + db2) * 2 + s2) * 64 + ln) * 8) = wv;
        }
    }
    float2* lam = (float2*)(p.ws + W_LAM); float2* lam64 = (float2*)(p.ws + W_LAM64);
    bf16_t* bbarF = (bf16_t*)(p.ws + W_BBARF); bf16_t* cmF = (bf16_t*)(p.ws + W_CMF);
    for (int e = gsz - 1 - gtid; e < 32 * 64 * 16; e += gsz) {
        const int i = e >> 4, h = e & 15, g = i >> 6, n = i & 63;
        float fre, fim; float2 lv, l64v; p0_ssm_f(p, i, fre, fim, lv, l64v);
        if (h == 0) { lam[i] = lv; lam64[i] = l64v; }
        const float Br = p.B_re[(size_t)i * 16 + h], Bi = p.B_im[(size_t)i * 16 + h];
        const float bre = fre * Br - fim * Bi, bim = fre * Bi + fim * Br;
        const int cf0 = (n >= 32 ? 2 : 0), ln = (h >> 3) * 32 + (n & 31), j = h & 7;
        bbarF[((size_t)(g * 4 + cf0) * 64 + ln) * 8 + j] = f2bf(bre);
        bbarF[((size_t)(g * 4 + cf0 + 1) * 64 + ln) * 8 + j] = f2bf(bim);
        const int ho = h;
        const float cre = p.C_re[(size_t)(g * 16 + ho) * 64 + n], cim = p.C_im[(size_t)(g * 16 + ho) * 64 + n];
#pragma unroll
        for (int part = 0; part < 2; ++part) {
            const int kk = 2 * n + part, ks = kk >> 5, q = (kk & 31) >> 3, jj = kk & 7, ln2 = q * 16 + ho;
            cmF[((size_t)(g * 4 + ks) * 64 + ln2) * 8 + jj] = f2bf(part ? -cim : cre);
        }
    }
}

template <bool SAMPLE>
DEVI int attn_blk(int kb, int ia, int b, int q0) {
    if (SAMPLE) return 514 + ia * 5 + kb;
    int kpos0 = q0 - 128 + 32 * kb; kpos0 = kpos0 < 0 ? 0 : kpos0;
    return b * 257 + (kpos0 >> 5);
}
DEVI void attn_load_k(const P& p, int blk, int kvh, int lane, bf16x8 (&kfr)[4]) {
    const bf16_t* kF = (const bf16_t*)(p.ws + W_KF);
#pragma unroll
    for (int ks = 0; ks < 4; ++ks) kfr[ks] = *(const bf16x8*)(kF + ((size_t)((kvh * NBLK + blk) * 4 + ks) * 64 + lane) * 8);
}
DEVI void attn_load_v(const P& p, int blk, int kvh, int lane, bf16x8 (&vfr)[2][2]) {
    const bf16_t* vF = (const bf16_t*)(p.ws + W_VF);
#pragma unroll
    for (int db2 = 0; db2 < 2; ++db2)
#pragma unroll
        for (int s2 = 0; s2 < 2; ++s2) vfr[db2][s2] = *(const bf16x8*)(vF + ((size_t)(((kvh * NBLK + blk) * 2 + db2) * 2 + s2) * 64 + lane) * 8);
}

template <bool SAMPLE>
DEVI void attn_unit(const P& p, int ia, int ib, int ic) {
    const int lane = tidx() & 63, c5 = lane & 31, h = lane >> 5;
    const bf16_t* qb = (const bf16_t*)(p.ws + W_QB);
    int rowq, head, kvh, b = 0, q0 = 0; bool qok;
    if (SAMPLE) { const int db = ia; kvh = ib; head = kvh * 4 + (c5 & 3); rowq = NPR + db * 8 + (c5 >> 2); qok = true; }
    else { b = ia; head = ib; kvh = head >> 2; q0 = ic * 32; rowq = b * LP + q0 + c5; qok = (q0 + c5) < LP; }
    bf16x8 kfr[5][4], vfr[3][2][2];
#pragma unroll
    for (int kb = 0; kb < 5; ++kb) attn_load_k(p, attn_blk<SAMPLE>(kb, ia, b, q0), kvh, lane, kfr[kb]);
    bf16x8 qf[4];
#pragma unroll
    for (int ks = 0; ks < 4; ++ks) qf[ks] = *(const bf16x8*)(qb + (size_t)rowq * 512 + head * 64 + ks * 16 + h * 8);
#pragma unroll
    for (int kb = 0; kb < 3; ++kb) attn_load_v(p, attn_blk<SAMPLE>(kb, ia, b, q0), kvh, lane, vfr[kb]);
    float m = p.sinks[head] * LOG2E, lsum = h == 0 ? 1.f : 0.f;
    f32x16 O[2];
#pragma unroll
    for (int i = 0; i < 16; ++i) { O[0][i] = 0.f; O[1][i] = 0.f; }
    const int tq = SAMPLE ? (c5 >> 2) : c5;
    auto body = [&](int kb, const bf16x8 (&kf)[4], const bf16x8 (&vf)[2][2]) {
        const bool blk_ok = SAMPLE ? true : (q0 - 128 + 32 * kb) >= 0;
        f32x16 S;
#pragma unroll
        for (int i = 0; i < 16; ++i) S[i] = 0.f;
#pragma unroll
        for (int ks = 0; ks < 4; ++ks) S = mfma32(kf[ks], qf[ks], S);
        float mx = -3.0e38f;
#pragma unroll
        for (int i = 0; i < 16; ++i) {
            const int ki = (i & 3) + 8 * (i >> 2) + 4 * h;
            bool valid = blk_ok;
            if (kb == 0) valid = valid && (ki > tq); else if (kb == 4) valid = valid && (ki <= tq);
            S[i] = valid ? S[i] : -3.0e38f;
            mx = fmaxf(mx, S[i]);
        }
        mx = fmaxf(mx, __shfl_xor(mx, 32));
        const float mnew = fmaxf(m, mx), alpha = exp2f(m - mnew); m = mnew;
        float ps = 0.f; float pv[16];
#pragma unroll
        for (int i = 0; i < 16; ++i) { pv[i] = exp2f(S[i] - mnew); ps += pv[i]; }
        lsum = lsum * alpha + ps;
#pragma unroll
        for (int i = 0; i < 16; ++i) { O[0][i] *= alpha; O[1][i] *= alpha; }
        const bf16x8 pf0 = mk8(pk2(pv[0], pv[1]), pk2(pv[2], pv[3]), pk2(pv[4], pv[5]), pk2(pv[6], pv[7]));
        const bf16x8 pf1 = mk8(pk2(pv[8], pv[9]), pk2(pv[10], pv[11]), pk2(pv[12], pv[13]), pk2(pv[14], pv[15]));
#pragma unroll
        for (int db2 = 0; db2 < 2; ++db2) { O[db2] = mfma32(vf[db2][0], pf0, O[db2]); O[db2] = mfma32(vf[db2][1], pf1, O[db2]); }
    };
    body(0, kfr[0], vfr[0]);
    attn_load_v(p, attn_blk<SAMPLE>(3, ia, b, q0), kvh, lane, vfr[0]);
    body(1, kfr[1], vfr[1]);
    attn_load_v(p, attn_blk<SAMPLE>(4, ia, b, q0), kvh, lane, vfr[1]);
    body(2, kfr[2], vfr[2]);
    body(3, kfr[3], vfr[0]);
    body(4, kfr[4], vfr[1]);
    lsum += __shfl_xor(lsum, 32);
    const float inv = 1.f / lsum;
    const bf16_t* ga = (const bf16_t*)(p.ws + W_GA) + (size_t)rowq * 512 + head * 64;
    const int rowq3 = row3_of(rowq);
    bf16_t* ao = (bf16_t*)(p.ws + W_CAT) + (size_t)rowq3 * 1024 + head * 64;
    float ssq = 0.f;
#pragma unroll
    for (int db2 = 0; db2 < 2; ++db2)
#pragma unroll
        for (int a = 0; a < 4; ++a) {
            const int d0 = db2 * 32 + 8 * a + 4 * h;
            const u32x2 gw = qok ? *(const u32x2*)(ga + d0) : (u32x2){0u, 0u};
            const float g0 = bflo(gw[0]), g1 = bfhi(gw[0]), g2 = bflo(gw[1]), g3 = bfhi(gw[1]);
            const float o0 = O[db2][4 * a] * inv * silu_f(g0), o1 = O[db2][4 * a + 1] * inv * silu_f(g1), o2 = O[db2][4 * a + 2] * inv * silu_f(g2), o3 = O[db2][4 * a + 3] * inv * silu_f(g3);
            ssq += o0 * o0 + o1 * o1 + o2 * o2 + o3 * o3;
            if (qok) { u32x2 w = {pk2(o0, o1), pk2(o2, o3)}; *(u32x2*)(ao + d0) = w; }
        }
    ssq += __shfl_xor(ssq, 32);
    if (qok && h == 0) ((float*)(p.ws + W_SSQA))[(size_t)rowq3 * 8 + head] = ssq;
}

template <bool PASS2, bool FULLV = false>
DEVI void ssm_item(const P& p, char* wlds, bool sample, int ia, int g, int c) {
    const int lane = tidx() & 63, c5 = lane & 31, hh = lane >> 5;
    const bf16_t* uG = (const bf16_t*)(p.ws + W_UG) + (size_t)g * NROWS_PAD * 16;
    const float2* lamT = (const float2*)(p.ws + W_LAM) + g * 64; const float2* lam64T = (const float2*)(p.ws + W_LAM64) + g * 64;
    const float2 l0 = lamT[c5], l1 = lamT[32 + c5];
    int rowbase, nvalid, nrb;
    if (sample) { rowbase = NPR + (2 * ia + hh) * 8; nvalid = 8; nrb = 1; }
    else { const int pos0 = c * 128 + 64 * hh; rowbase = ia * LP + pos0; nvalid = LP - pos0; nvalid = nvalid < 0 ? 0 : (nvalid > 64 ? 64 : nvalid); nrb = c == 64 ? 1 : 4; }
    bf16x8 bfr[4];
#pragma unroll
    for (int cf = 0; cf < 4; ++cf) bfr[cf] = *(const bf16x8*)((const bf16_t*)(p.ws + W_BBARF) + ((size_t)(g * 4 + cf) * 64 + lane) * 8);
    const int ar_ = lane & 31, ahalf_ = (ar_ >> 2) & 1, aidx_ = (ar_ & 3) + 4 * (ar_ >> 3);
    u32x4 uall[4]; u32x2 dall[4][2];
    { int rbase_a, nv_a;
      if (sample) { rbase_a = NPR + (2 * ia + ahalf_) * 8; nv_a = 8; } else { const int pos0 = c * 128 + 64 * ahalf_; rbase_a = ia * LP + pos0; nv_a = LP - pos0; nv_a = nv_a < 0 ? 0 : (nv_a > 64 ? 64 : nv_a); }
#pragma unroll
      for (int rb = 0; rb < 4; ++rb) { const int ti = rb * 16 + aidx_; uall[rb] = (u32x4){0u, 0u, 0u, 0u};
          if (rb < nrb && ti < nv_a) uall[rb] = *(const u32x4*)(uG + (size_t)(rbase_a + ti) * 16 + (lane >> 5) * 8); }
      if (PASS2) {
#pragma unroll
          for (int tb = 0; tb < 2; ++tb) { int rb_base, nv_t;
              if (sample) { rb_base = NPR + (2 * ia + tb) * 8; nv_t = 8; } else { const int pos0 = c * 128 + 64 * tb; rb_base = ia * LP + pos0; nv_t = LP - pos0; nv_t = nv_t < 0 ? 0 : (nv_t > 64 ? 64 : nv_t); }
#pragma unroll
              for (int rb = 0; rb < 4; ++rb) { const int ti = rb * 16 + (lane & 15); dall[rb][tb] = (u32x2){0u, 0u};
                  if (rb < nrb && ti < nv_t) dall[rb][tb] = *(const u32x2*)(uG + (size_t)(rb_base + ti) * 16 + (lane >> 4) * 4); } }
      }
    }
    float x0r = 0.f, x0i = 0.f, x1r = 0.f, x1i = 0.f;
    if (PASS2) {
        if (sample) { const size_t o = ((size_t)(2 * ia + hh) * 32 + g) * 64; x0r = p.st_re[o + c5]; x0i = p.st_im[o + c5]; x1r = p.st_re[o + 32 + c5]; x1i = p.st_im[o + 32 + c5]; }
        else {
            int sc = 2 * c + hh; sc = sc > 128 ? 128 : sc;
            const float2* cy = (const float2*)(p.ws + W_CARRY) + ((size_t)(ia * 32 + g) * 129 + sc) * 64;
            const float2 c0 = cy[c5], c1 = cy[32 + c5];
            x0r = c0.x; x0i = c0.y; x1r = c1.x; x1i = c1.y;
        }
    }
    bf16x8 cfr[4];
    float dsk[4];
    if (PASS2) {
#pragma unroll
        for (int ks = 0; ks < 4; ++ks) cfr[ks] = *(const bf16x8*)((const bf16_t*)(p.ws + W_CMF) + ((size_t)(g * 4 + ks) * 64 + lane) * 8);
        const f32x4 d4 = *(const f32x4*)(p.Dk + g * 16 + (lane >> 4) * 4);
        dsk[0] = d4[0]; dsk[1] = d4[1]; dsk[2] = d4[2]; dsk[3] = d4[3];
    }
#pragma unroll
    for (int rb = 0; rb < 4; ++rb) {
        if (rb >= nrb) break;
        {
          const bf16x8 af = __builtin_bit_cast(bf16x8, uall[rb]);
          f32x16 bu[4];
#pragma unroll
          for (int cf = 0; cf < 4; ++cf) {
#pragma unroll
              for (int i = 0; i < 16; ++i) bu[cf][i] = 0.f;
              bu[cf] = mfma32(af, bfr[cf], bu[cf]);
          }
          const int nv_here = nvalid - rb * 16;
          unsigned* xw = (unsigned*)wlds;
#pragma unroll
          for (int i = 0; i < 16; ++i) {
              const float a = l0.x * x0r - l0.y * x0i + bu[0][i], bq = l0.x * x0i + l0.y * x0r + bu[1][i];
              const float cc = l1.x * x1r - l1.y * x1i + bu[2][i], dq = l1.x * x1i + l1.y * x1r + bu[3][i];
              if (PASS2 && !FULLV) { const bool v = i < nv_here; x0r = v ? a : x0r; x0i = v ? bq : x0i; x1r = v ? cc : x1r; x1i = v ? dq : x1i; }
              else { x0r = a; x0i = bq; x1r = cc; x1i = dq; }
              if (PASS2) { xw[(hh * 16 + i) * 68 + c5] = pk2(x0r, x0i); xw[(hh * 16 + i) * 68 + 32 + c5] = pk2(x1r, x1i); }
          }
        }
        if (PASS2) {
#pragma unroll
            for (int tb = 0; tb < 2; ++tb) {
                f32x4 y = {0.f, 0.f, 0.f, 0.f};
#pragma unroll
                for (int ks = 0; ks < 4; ++ks) {
                    const bf16x8 xf = *(const bf16x8*)(wlds + (tb * 16 + (lane & 15)) * 272 + ks * 64 + (lane >> 4) * 16);
                    y = mfma16(cfr[ks], xf, y);
                }
                int rb_base, nv_t;
                if (sample) { rb_base = NPR + (2 * ia + tb) * 8; nv_t = 8; } else { const int pos0 = c * 128 + 64 * tb; rb_base = ia * LP + pos0; nv_t = LP - pos0; nv_t = nv_t < 0 ? 0 : (nv_t > 64 ? 64 : nv_t); }
                const int ti = rb * 16 + (lane & 15);
                if (ti < nv_t) {
                    const int row = rb_base + ti;
                    const u32x2 uw = dall[rb][tb];
                    const float y0 = y[0] + dsk[0] * bflo(uw[0]), y1 = y[1] + dsk[1] * bfhi(uw[0]), y2 = y[2] + dsk[2] * bflo(uw[1]), y3 = y[3] + dsk[3] * bfhi(uw[1]);
                    u32x2 w = {pk2(gelu_tanh(y0), gelu_tanh(y1)), pk2(gelu_tanh(y2), gelu_tanh(y3))};
                    *(u32x2*)(gb_base(p.ws, sample) + (size_t)row3_of(row) * 512 + g * 16 + (lane >> 4) * 4) = w;
                }
            }
        }
    }
    if (!PASS2) {
        float2* ends = (float2*)(p.ws + W_ENDS) + (size_t)(ia * 32 + g) * 128 * 64 + (size_t)(2 * c + hh) * 64;
        ends[c5] = make_float2(x0r, x0i); ends[32 + c5] = make_float2(x1r, x1i);
    } else {
        if (sample) { const size_t o = ((size_t)(2 * ia + hh) * 32 + g) * 64;
            p.out[O_SRS + o + c5] = x0r; p.out[O_SIS + o + c5] = x0i; p.out[O_SRS + o + 32 + c5] = x1r; p.out[O_SIS + o + 32 + c5] = x1i; }
        else if (c == 64 && hh == 0) { const size_t o = ((size_t)ia * 32 + g) * 64;
            p.out[O_SRP + o + c5] = x0r; p.out[O_SIP + o + c5] = x0i; p.out[O_SRP + o + 32 + c5] = x1r; p.out[O_SIP + o + 32 + c5] = x1i; }
    }
}

DEVI void phase2a(const P& p, char* lds) {
    const int tid = tidx(), wid = tid >> 6, lane = tid & 63;
    if (blockIdx.x < 64) {
        const int bg = blockIdx.x, g = bg & 31, b = bg >> 5;
#pragma unroll 1
        for (int k = 0; k < 8; ++k) ssm_item<false>(p, lds + wid * 8704, false, b, g, wid * 8 + k);
        asm volatile("s_waitcnt vmcnt(0)" ::: "memory");
        __syncthreads();
        const float2 L = ((const float2*)(p.ws + W_LAM64))[g * 64 + lane];
        const float2* ends = (const float2*)(p.ws + W_ENDS) + (size_t)bg * 128 * 64 + (size_t)(16 * wid) * 64 + lane;
        float2 e[16];
#pragma unroll
        for (int s = 0; s < 16; ++s) e[s] = ends[s * 64];
        float xr = 0.f, xi = 0.f;
#pragma unroll
        for (int s = 0; s < 16; ++s) { const float a = L.x * xr - L.y * xi + e[s].x, bq = L.x * xi + L.y * xr + e[s].y; xr = a; xi = bq; }
        float pr = L.x, pi = L.y;
#pragma unroll
        for (int k = 0; k < 4; ++k) { const float a = pr * pr - pi * pi, bq = 2.f * pr * pi; pr = a; pi = bq; }
        float2* seg = (float2*)lds;
        seg[wid * 64 + lane] = make_float2(xr, xi);
        __syncthreads();
        float cr = 0.f, ci = 0.f;
        for (int i = 0; i < wid; ++i) { const float2 q = seg[i * 64 + lane]; const float a = pr * cr - pi * ci + q.x, bq = pr * ci + pi * cr + q.y; cr = a; ci = bq; }
        float2* cy = (float2*)(p.ws + W_CARRY) + (size_t)bg * 129 * 64 + (size_t)(16 * wid) * 64 + lane;
        xr = cr; xi = ci;
#pragma unroll
        for (int s = 0; s < 16; ++s) { cy[s * 64] = make_float2(xr, xi); const float a = L.x * xr - L.y * xi + e[s].x, bq = L.x * xi + L.y * xr + e[s].y; xr = a; xi = bq; }
        if (wid == 7) cy[16 * 64] = make_float2(xr, xi);
        __syncthreads();
    } else {
        const int vb0 = (int)blockIdx.x - 64;
        const int w = ((vb0 & 7) * 24 + (vb0 >> 3)) * 8 + wid;
        for (int u = w; u < 4096; u += 1536) { const int head = u & 7, r = u >> 3, qblk = r & 255, b = r >> 8; attn_unit<false>(p, b, head, qblk); }
        { const int e = w - 1024; if (e >= 0 && e < 16) attn_unit<false>(p, e >> 3, e & 7, 256); }
        { const int s = w - 1024 - 16; if (s >= 0 && s < 256) attn_unit<true>(p, s >> 1, s & 1, 0); }
        if (w < 1296) ssm_item<true>(p, lds + wid * 8704, true, w >> 5, w & 31, 0);
        else for (int u = w; u < 2048; u += 240) ssm_item<true>(p, lds + wid * 8704, true, u >> 5, u & 31, 0);
    }
}
DEVI void phase2b(const P& p, char* lds) {
    const int wid = tidx() >> 6;
    for (int it = blockIdx.x * 8 + wid; it < 4096; it += 232 * 8) { const int c = it & 63, g = (it >> 6) & 31, b = it >> 11; ssm_item<true, true>(p, lds + wid * 8704, false, b, g, c); }
    for (int it = (231 - (int)blockIdx.x) * 8 + wid; it < 64; it += 232 * 8) ssm_item<true, false>(p, lds + wid * 8704, false, it >> 5, it & 31, 64);
}

namespace pg8 {
#define PG8_LAS __attribute__((address_space(3)))
constexpr int BM = 256, BK = 64, HALF = 128, HTB = HALF * BK * 2  , STAGE_BYTES = 8 * HTB, NXCD = 8, WGM = 8;
__host__ __device__ __forceinline__ int lds_byte(int r, int c) { const int st = (r >> 4) * 2 + (c >> 5), rr = r & 15, cc = c & 31, ob = rr * 64 + cc * 2; return st * 1024 + (ob ^ (((ob >> 9) & 1) << 5)); }
__host__ __device__ __forceinline__ void stage_rc(int b, int& R, int& C) { const int st = b / 1024, sb = b % 1024, swz = sb ^ (((sb >> 9) & 1) << 5); R = (st >> 1) * 16 + swz / 64; C = (st & 1) * 32 + (swz % 64) / 2; }
__host__ __device__ __forceinline__ int perm32(int rho) { const int n = rho >> 4, i = rho & 15; return 8 * (i >> 2) + 4 * n + (i & 3); }
struct Unit { int pm, pn; };
struct Gemm { const bf16_t* A; const bf16_t* Bt; int lda, ldb, K; };
struct StaticOrder {
    int nM, nN, nwg, G, c;
    __host__ __device__ void init(int M, int N, int G_, int c_) { nM = M / BM; nN = N / BM; nwg = nM * nN; G = G_; c = c_; }
    __host__ __device__ bool next(int i, Unit& u) const {
        const long L = (long)i * G + c; if (L >= nwg) return false;
        int wgid = (int)L; { const int q = nwg / NXCD, r = nwg % NXCD, xcd = wgid % NXCD, off = wgid / NXCD; wgid = (xcd < r ? xcd * (q + 1) : r * (q + 1) + (xcd - r) * q) + off; }
        const int nig = WGM * nN, gid = wgid / nig, fm = gid * WGM, gsz = (nM - fm) < WGM ? (nM - fm) : WGM;
        u.pm = fm + ((wgid % nig) % gsz); u.pn = (wgid % nig) / gsz; return true;
    }
};
template <class Epi, class Sched>
__device__ __forceinline__ void gemm_phase(PG8_LAS unsigned char* lds, const Gemm g, const Sched& S, const Epi& E) {
    const int tid = tidx(), wid = __builtin_amdgcn_readfirstlane(tid >> 6), lane = tid & 63, wr = wid >> 2, wc = wid & 3, fr = lane & 15, fq = lane >> 4;
    const int K = g.K, nt = K / BK;
    unsigned voffA[2], voffB[2];
#pragma unroll
    for (int i = 0; i < 2; ++i) { int R, C; stage_rc(tid * 16 + i * 8192, R, C); const int Rb = (R & ~31) + perm32(R & 31); voffA[i] = (unsigned)(R * g.lda + C) * 2u; voffB[i] = (unsigned)(Rb * g.ldb + C) * 2u; }
    const size_t kstep = (size_t)(BK * 2);
    const size_t hstepA = (size_t)HALF * g.lda * 2, hstepB = (size_t)HALF * g.ldb * 2;
    const size_t tstepA = 2 * hstepA, tstepB = 2 * hstepB;
    const unsigned ldsw = (unsigned)wid * 1024u;
    const int aoff = lds_byte(wr * 64 + fr, fq * 8), boff = lds_byte(wc * 32 + fr, fq * 8);
#define PG8_SA(b, h) (((b) * 2 + (h)) * HTB)
#define PG8_SB(b, h) ((4 + (b) * 2 + (h)) * HTB)
#define PG8_STAGE(bufoff, gbase, voff) do { _Pragma("unroll") for (int _i = 0; _i < 2; ++_i) \
        __builtin_amdgcn_global_load_lds((const unsigned*)((const char*)(gbase) + (voff)[_i]), (PG8_LAS unsigned*)(lds + (bufoff) + ldsw + _i * 8192), 16, 0, 0); } while (0)
#define PG8_LDA(dst, b, h) do { _Pragma("unroll") for (int m = 0; m < 4; ++m) _Pragma("unroll") for (int k = 0; k < 2; ++k) dst[m][k] = *(const PG8_LAS bf16x8*)(lds + PG8_SA(b, h) + aoff + m * 2048 + k * 1024); } while (0)
#define PG8_LDB(dst, b, h) do { _Pragma("unroll") for (int n = 0; n < 2; ++n) _Pragma("unroll") for (int k = 0; k < 2; ++k) dst[n][k] = *(const PG8_LAS bf16x8*)(lds + PG8_SB(b, h) + boff + n * 2048 + k * 1024); } while (0)
#define PG8_MMA(ai, bj, At, Bt) do { __builtin_amdgcn_s_setprio(1); _Pragma("unroll") for (int m = 0; m < 4; ++m) _Pragma("unroll") for (int n = 0; n < 2; ++n) _Pragma("unroll") for (int k = 0; k < 2; ++k) \
        acc[ai][bj][m][n] = __builtin_amdgcn_mfma_f32_16x16x32_bf16(Bt[n][k], At[m][k], acc[ai][bj][m][n], 0, 0, 0); __builtin_amdgcn_s_setprio(0); } while (0)
#define PG8_WAIT_V(n) asm volatile("s_waitcnt vmcnt(" #n ")" ::: "memory")
#define PG8_WAIT_L(n) asm volatile("s_waitcnt lgkmcnt(" #n ")" ::: "memory")
#define PG8_BAR __builtin_amdgcn_s_barrier()
#define PG8_SCHED __builtin_amdgcn_sched_barrier(0)
    Unit cur, nxt; int ui = 0;
    if (!S.next(0, cur)) return;
    f32x4 acc[2][2][4][2];
#pragma unroll
    for (int a = 0; a < 2; ++a)
#pragma unroll
        for (int b = 0; b < 2; ++b)
#pragma unroll
            for (int m = 0; m < 4; ++m)
#pragma unroll
                for (int n = 0; n < 2; ++n) acc[a][b][m][n] = (f32x4){0.f, 0.f, 0.f, 0.f};
    bf16x8 At[4][2], B0[2][2], B1[2][2];
    const char* cA = (const char*)g.A + (size_t)cur.pm * tstepA; const char* cB = (const char*)g.Bt + (size_t)cur.pn * tstepB;
    E.begin(cur, 0, tid, lds);
    asm volatile("s_waitcnt vmcnt(0) lgkmcnt(0)" ::: "memory");
    PG8_BAR;
    PG8_STAGE(PG8_SB(0, 0), cB, voffB); PG8_STAGE(PG8_SB(0, 1), cB + hstepB, voffB); PG8_STAGE(PG8_SA(0, 0), cA, voffA); PG8_STAGE(PG8_SA(0, 1), cA + hstepA, voffA);
    if (wr == 1) PG8_BAR;
    PG8_WAIT_V(2); PG8_BAR;
    PG8_STAGE(PG8_SB(1, 0), cB + kstep, voffB); PG8_STAGE(PG8_SA(1, 0), cA + kstep, voffA); PG8_STAGE(PG8_SB(1, 1), cB + hstepB + kstep, voffB);
    PG8_WAIT_V(6); PG8_BAR;
    for (;;) {
        const bool has_next = S.next(ui + 1, nxt);
        const char* nA = has_next ? (const char*)g.A + (size_t)nxt.pm * tstepA : cA; const char* nB = has_next ? (const char*)g.Bt + (size_t)nxt.pn * tstepB : cB;
        for (int t = 0; t < nt; t += 2) {
            const bool last = (t == nt - 2);
            const char* a1 = cA + (size_t)(t + 1) * kstep;
            const char* a2 = last ? nA : cA + (size_t)(t + 2) * kstep; const char* b2 = last ? nB : cB + (size_t)(t + 2) * kstep;
            const char* a3 = a2 + kstep; const char* b3 = b2 + kstep;
            if constexpr (Epi::HAS_MID) { if (t == nt / 2) E.mid(acc, wr, fr, ui, lds); }
            PG8_LDB(B0, 0, 0); PG8_LDB(B1, 0, 1); PG8_SCHED; PG8_LDA(At, 0, 0); PG8_STAGE(PG8_SA(1, 1), a1 + hstepA, voffA);
            PG8_WAIT_V(8); PG8_WAIT_L(0); PG8_BAR; PG8_MMA(0, 0, At, B0); PG8_MMA(0, 1, At, B1); PG8_BAR; PG8_SCHED;
            PG8_LDA(At, 0, 1); PG8_STAGE(PG8_SB(0, 0), b2, voffB); PG8_STAGE(PG8_SB(0, 1), b2 + hstepB, voffB); PG8_STAGE(PG8_SA(0, 0), a2, voffA);
            PG8_WAIT_V(8); PG8_WAIT_L(0); PG8_BAR; PG8_MMA(1, 0, At, B0); PG8_MMA(1, 1, At, B1); PG8_BAR; PG8_SCHED;
            PG8_LDB(B0, 1, 0); PG8_LDB(B1, 1, 1); PG8_SCHED; PG8_LDA(At, 1, 0); PG8_STAGE(PG8_SA(0, 1), a2 + hstepA, voffA);
            PG8_WAIT_V(8); PG8_WAIT_L(0); PG8_BAR; PG8_MMA(0, 0, At, B0); PG8_MMA(0, 1, At, B1); PG8_BAR; PG8_SCHED;
            PG8_LDA(At, 1, 1); PG8_STAGE(PG8_SB(1, 0), b3, voffB); PG8_STAGE(PG8_SB(1, 1), b3 + hstepB, voffB); PG8_STAGE(PG8_SA(1, 0), a3, voffA);
            PG8_WAIT_V(8); PG8_WAIT_L(0); PG8_BAR; PG8_MMA(1, 0, At, B0); PG8_MMA(1, 1, At, B1); PG8_BAR; PG8_SCHED;
        }
        if (wr == 0) PG8_BAR;
        E(acc, cur, wr, wc, fr, fq, ui, lds);
        if (!has_next) break;
#pragma unroll
        for (int a = 0; a < 2; ++a)
#pragma unroll
            for (int b = 0; b < 2; ++b)
#pragma unroll
                for (int m = 0; m < 4; ++m)
#pragma unroll
                    for (int n = 0; n < 2; ++n) acc[a][b][m][n] = (f32x4){0.f, 0.f, 0.f, 0.f};
        cur = nxt; cA = nA; cB = nB; ++ui;
        E.begin(cur, ui, tid, lds);
        if (wr == 1) PG8_BAR;
    }
    PG8_WAIT_V(0);
    PG8_BAR;
#undef PG8_SA
#undef PG8_SB
#undef PG8_STAGE
#undef PG8_LDA
#undef PG8_LDB
#undef PG8_MMA
#undef PG8_WAIT_V
#undef PG8_WAIT_L
#undef PG8_BAR
#undef PG8_SCHED
}
}

typedef const f32x4 (&AccRef)[2][2][4][2];

struct EpiP1 {
    static constexpr bool HAS_MID = false;
    P p;
    DEVI void begin(const pg8::Unit&, int, int, PG8_LAS unsigned char*) const {}
    DEVI void mid(f32x4 (&)[2][2][4][2], int, int, int, PG8_LAS unsigned char*) const {}
    DEVI void operator()(AccRef acc, const pg8::Unit& u, int wr, int wc, int fr, int fq, int, PG8_LAS unsigned char*) const {
        const float* rs = (const float*)(p.ws + W_RS);
        const int pn = u.pn;
        const int kind = pn < 2 ? 0 : (pn == 2 ? (wc < 2 ? 1 : 2) : (pn < 5 ? 3 : (pn < 7 ? 4 : 5)));
        float rs8[2][4];
#pragma unroll
        for (int ai = 0; ai < 2; ++ai)
#pragma unroll
            for (int m = 0; m < 4; ++m) rs8[ai][m] = rs[u.pm * 256 + ai * 128 + wr * 64 + m * 16 + fr];
        if (kind <= 1) {
            const float* nw = kind == 0 ? p.q_norm_w : p.k_norm_w;
            f32x4 w4[2][2];
#pragma unroll
            for (int bj = 0; bj < 2; ++bj)
#pragma unroll
                for (int n = 0; n < 2; ++n) w4[bj][n] = *(const f32x4*)(nw + 32 * bj + 8 * fq + 4 * n);
            const float2* rope = (const float2*)(p.ws + W_ROPE);
#pragma unroll
            for (int ai = 0; ai < 2; ++ai)
#pragma unroll
                for (int m = 0; m < 4; ++m) {
                    const int row = u.pm * 256 + ai * 128 + wr * 64 + m * 16 + fr;
                    const float rsv = rs8[ai][m];
                    const bool isp = row < NPR; const int b = row >= LP ? 1 : 0;
                    const int pos = isp ? row - b * LP : 8192 + ((row - NPR) & 7);
                    float v[2][2][4]; float ss = 0.f;
#pragma unroll
                    for (int bj = 0; bj < 2; ++bj)
#pragma unroll
                        for (int n = 0; n < 2; ++n)
#pragma unroll
                            for (int j = 0; j < 4; ++j) { v[bj][n][j] = acc[ai][bj][m][n][j] * rsv; ss += v[bj][n][j] * v[bj][n][j]; }
                    ss += __shfl_xor(ss, 16); ss += __shfl_xor(ss, 32);
                    const float rinv = rsqrtf(ss * (1.f / 64.f) + EPS);
                    const int rpos = pos < LP ? pos : LP - 1;
#pragma unroll
                    for (int n = 0; n < 2; ++n) {
                        const f32x4 cs0 = *(const f32x4*)(rope + (size_t)rpos * 32 + 8 * fq + 4 * n);
                        const f32x4 cs1 = *(const f32x4*)(rope + (size_t)rpos * 32 + 8 * fq + 4 * n + 2);
                        const float c[4] = {cs0[0], cs0[2], cs1[0], cs1[2]}, s[4] = {cs0[1], cs0[3], cs1[1], cs1[3]};
#pragma unroll
                        for (int j = 0; j < 4; ++j) { const float x1 = v[0][n][j] * rinv * w4[0][n][j], x2 = v[1][n][j] * rinv * w4[1][n][j];
                            v[0][n][j] = x1 * c[j] - x2 * s[j]; v[1][n][j] = x2 * c[j] + x1 * s[j]; }
                    }
                    if (kind == 0) {
                        if (row < NROWS) { bf16_t* qb = (bf16_t*)(p.ws + W_QB) + (size_t)row * 512 + (pn * 4 + wc) * 64 + 8 * fq;
#pragma unroll
                            for (int bj = 0; bj < 2; ++bj) { u32x4 w = {pk2(v[bj][0][0] * QSCALE, v[bj][0][1] * QSCALE), pk2(v[bj][0][2] * QSCALE, v[bj][0][3] * QSCALE), pk2(v[bj][1][0] * QSCALE, v[bj][1][1] * QSCALE), pk2(v[bj][1][2] * QSCALE, v[bj][1][3] * QSCALE)};
                                *(u32x4*)(qb + 32 * bj) = w; } }
                    } else {
                        const int kvh = wc;
                        if (row < NROWS) {
                            const int blk = isp ? b * 257 + (pos >> 5) : 514 + ((row - NPR) >> 3) * 5 + 4, key = isp ? (pos & 31) : ((row - NPR) & 7);
                            bf16_t* kF = (bf16_t*)(p.ws + W_KF);
#pragma unroll
                            for (int bj = 0; bj < 2; ++bj) { u32x4 w = {pk2(v[bj][0][0], v[bj][0][1]), pk2(v[bj][0][2], v[bj][0][3]), pk2(v[bj][1][0], v[bj][1][1]), pk2(v[bj][1][2], v[bj][1][3])};
                                *(u32x4*)(kF + ((size_t)((kvh * NBLK + blk) * 4 + 2 * bj + (fq >> 1)) * 64 + (fq & 1) * 32 + key) * 8) = w; }
                        }
                        if (isp) {
                            if (pos >= LP - 128) { float* o = p.out + O_KWP + ((size_t)(b * 128 + pos - (LP - 128)) * 2 + kvh) * 64 + 8 * fq;
#pragma unroll
                                for (int bj = 0; bj < 2; ++bj)
#pragma unroll
                                    for (int n = 0; n < 2; ++n) *(f32x4*)(o + 32 * bj + 4 * n) = (f32x4){v[bj][n][0], v[bj][n][1], v[bj][n][2], v[bj][n][3]}; }
                        } else if (row < NROWS) { float* o = p.out + O_KNS + ((size_t)(row - NPR) * 2 + kvh) * 64 + 8 * fq;
#pragma unroll
                            for (int bj = 0; bj < 2; ++bj)
#pragma unroll
                                for (int n = 0; n < 2; ++n) *(f32x4*)(o + 32 * bj + 4 * n) = (f32x4){v[bj][n][0], v[bj][n][1], v[bj][n][2], v[bj][n][3]}; }
                    }
                    if (m & 1) asm volatile("" ::: "memory");
                }
        } else if (kind == 2) {
            const int kvh = wc - 2;
#pragma unroll
            for (int ai = 0; ai < 2; ++ai)
#pragma unroll
                for (int m = 0; m < 4; ++m) {
                    const int row = u.pm * 256 + ai * 128 + wr * 64 + m * 16 + fr;
                    const float rsv = rs8[ai][m];
                    const bool isp = row < NPR; const int b = row >= LP ? 1 : 0;
                    const int pos = isp ? row - b * LP : 0;
                    if (row < NROWS) {
                        const int blk = isp ? b * 257 + (pos >> 5) : 514 + ((row - NPR) >> 3) * 5 + 4, kk = isp ? (pos & 31) : ((row - NPR) & 7), s2 = kk >> 4, r16 = kk & 15, jj = (r16 >> 3) * 4 + (r16 & 3), hh = (r16 >> 2) & 1;
                        bf16_t* vF = (bf16_t*)(p.ws + W_VF);
#pragma unroll
                        for (int bj = 0; bj < 2; ++bj)
#pragma unroll
                            for (int n = 0; n < 2; ++n)
#pragma unroll
                                for (int j = 0; j < 4; ++j)
                                    vF[((size_t)(((kvh * NBLK + blk) * 2 + bj) * 2 + s2) * 64 + hh * 32 + (8 * fq + 4 * n + j)) * 8 + jj] = f2bf(acc[ai][bj][m][n][j] * rsv);
                    }
                    if (isp) {
                        if (pos >= LP - 128) { float* o = p.out + O_VWP + ((size_t)(b * 128 + pos - (LP - 128)) * 2 + kvh) * 64 + 8 * fq;
#pragma unroll
                            for (int bj = 0; bj < 2; ++bj)
#pragma unroll
                                for (int n = 0; n < 2; ++n) *(f32x4*)(o + 32 * bj + 4 * n) = acc[ai][bj][m][n] * rsv; }
                    } else if (row < NROWS) { float* o = p.out + O_VNS + ((size_t)(row - NPR) * 2 + kvh) * 64 + 8 * fq;
#pragma unroll
                        for (int bj = 0; bj < 2; ++bj)
#pragma unroll
                            for (int n = 0; n < 2; ++n) *(f32x4*)(o + 32 * bj + 4 * n) = acc[ai][bj][m][n] * rsv; }
                    asm volatile("" ::: "memory");
                }
        } else if (kind == 4) {
            bf16_t* uG = (bf16_t*)(p.ws + W_UG);
#pragma unroll
            for (int ai = 0; ai < 2; ++ai)
#pragma unroll
                for (int m = 0; m < 4; ++m) {
                    const int row = u.pm * 256 + ai * 128 + wr * 64 + m * 16 + fr;
                    const float rsv = rs8[ai][m];
                    if (row < NROWS) {
#pragma unroll
                        for (int bj = 0; bj < 2; ++bj) { const int g = (pn - 5) * 16 + 4 * wc + 2 * bj + (fq >> 1); const f32x4 t0 = acc[ai][bj][m][0] * rsv, t1 = acc[ai][bj][m][1] * rsv;
                            u32x4 w = {pk2(t0[0], t0[1]), pk2(t0[2], t0[3]), pk2(t1[0], t1[1]), pk2(t1[2], t1[3])}; *(u32x4*)(uG + ((size_t)g * NROWS_PAD + row) * 16 + 8 * (fq & 1)) = w; }
                    }
                }
        } else {
            bf16_t* dst0 = (bf16_t*)(p.ws + (kind == 3 ? W_GA : W_GS)) + (kind == 3 ? pn - 3 : pn - 7) * 256 + 64 * wc + 8 * fq;
#pragma unroll
            for (int ai = 0; ai < 2; ++ai)
#pragma unroll
                for (int m = 0; m < 4; ++m) {
                    const int row = u.pm * 256 + ai * 128 + wr * 64 + m * 16 + fr;
                    const float rsv = rs8[ai][m];
                    if (row < NROWS) {
                        const int rowd = kind == 3 ? row : row3_of(row);
#pragma unroll
                        for (int bj = 0; bj < 2; ++bj) { const f32x4 t0 = acc[ai][bj][m][0] * rsv, t1 = acc[ai][bj][m][1] * rsv;
                            u32x4 w = {pk2(t0[0], t0[1]), pk2(t0[2], t0[3]), pk2(t1[0], t1[1]), pk2(t1[2], t1[3])}; *(u32x4*)(dst0 + (size_t)rowd * 512 + 32 * bj) = w; }
                    }
                }
        }
    }
};

struct EpiGlu {
    static constexpr bool HAS_MID = false;
    P p;
    DEVI void begin(const pg8::Unit&, int, int, PG8_LAS unsigned char*) const {}
    DEVI void mid(f32x4 (&)[2][2][4][2], int, int, int, PG8_LAS unsigned char*) const {}
    DEVI void operator()(AccRef acc, const pg8::Unit& u, int wr, int wc, int fr, int fq, int, PG8_LAS unsigned char*) const {
        const bf16_t* gB = gb_base(p.ws, u.pm >= 64); const bf16_t* gs = (const bf16_t*)(p.ws + W_GS);
        bf16_t* cat = (bf16_t*)(p.ws + W_CAT); float* ssqs = (float*)(p.ws + W_SSQS);
        const int f0 = u.pn * 256 + 32 * wc + 8 * fq;
        f32x4 bg[2][2];
#pragma unroll
        for (int bj = 0; bj < 2; ++bj)
#pragma unroll
            for (int n = 0; n < 2; ++n) bg[bj][n] = *(const f32x4*)(p.b_glu + f0 + 128 * bj + 4 * n);
#pragma unroll
        for (int ai = 0; ai < 2; ++ai)
#pragma unroll
            for (int m = 0; m < 4; ++m) {
                const int row = u.pm * 256 + ai * 128 + wr * 64 + m * 16 + fr;
                float ssq = 0.f;
#pragma unroll
                for (int bj = 0; bj < 2; ++bj) {
                    const int f = f0 + 128 * bj;
                    const u32x4 gw = *(const u32x4*)(gB + (size_t)row * 512 + f), sw = *(const u32x4*)(gs + (size_t)row * 512 + f);
                    float s[8];
#pragma unroll
                    for (int n = 0; n < 2; ++n)
#pragma unroll
                        for (int j = 0; j < 4; ++j) { const unsigned gwd = gw[2 * n + (j >> 1)], swd = sw[2 * n + (j >> 1)];
                            const float gl = (j & 1) ? bfhi(gwd) : bflo(gwd), gv = (j & 1) ? bfhi(swd) : bflo(swd);
                            s[4 * n + j] = gl * sigmoid_f(acc[ai][bj][m][n][j] + bg[bj][n][j]) * silu_f(gv); ssq += s[4 * n + j] * s[4 * n + j]; }
                    { u32x4 w = {pk2(s[0], s[1]), pk2(s[2], s[3]), pk2(s[4], s[5]), pk2(s[6], s[7])}; *(u32x4*)(cat + (size_t)row * 1024 + 512 + f) = w; }
                }
                ssq += __shfl_xor(ssq, 16); ssq += __shfl_xor(ssq, 32);
                if (fq == 0) ssqs[(size_t)row * 8 + u.pn * 4 + wc] = ssq;
                asm volatile("" ::: "memory");
            }
    }
};

constexpr int LDS_TAB = 131072;
struct EpiOut {
    static constexpr bool HAS_MID = true;
    P p;
    DEVI void begin(const pg8::Unit& u, int ui, int tid, PG8_LAS unsigned char* lds) const {
        if (tid < 256) {
            const int row = u.pm * 256 + tid;
            float ra = 1.f, rsv = 1.f;
            {
                const float* ssqa = (const float*)(p.ws + W_SSQA) + (size_t)row * 8; const float* ssqs = (const float*)(p.ws + W_SSQS) + (size_t)row * 8;
                const f32x4 a0 = *(const f32x4*)(ssqa), a1 = *(const f32x4*)(ssqa + 4), s0 = *(const f32x4*)(ssqs), s1 = *(const f32x4*)(ssqs + 4);
                ra = rsqrtf(((a0[0] + a0[1]) + (a0[2] + a0[3]) + (a1[0] + a1[1]) + (a1[2] + a1[3])) * (1.f / 512.f) + EPS);
                rsv = rsqrtf(((s0[0] + s0[1]) + (s0[2] + s0[3]) + (s1[0] + s1[1]) + (s1[2] + s1[3])) * (1.f / 512.f) + EPS);
            }
            ((PG8_LAS f32x2*)(lds + LDS_TAB))[(ui & 1) * 256 + tid] = (f32x2){ra / rsv, rsv};
        }
    }
    DEVI void mid(f32x4 (&acc)[2][2][4][2], int wr, int fr, int ui, PG8_LAS unsigned char* lds) const {
#pragma unroll
        for (int ai = 0; ai < 2; ++ai)
#pragma unroll
            for (int m = 0; m < 4; ++m) {
                const float sc = ((const PG8_LAS f32x2*)(lds + LDS_TAB))[(ui & 1) * 256 + ai * 128 + wr * 64 + m * 16 + fr].x;
#pragma unroll
                for (int bj = 0; bj < 2; ++bj)
#pragma unroll
                    for (int n = 0; n < 2; ++n) acc[ai][bj][m][n] *= sc;
            }
    }
    DEVI void operator()(AccRef acc, const pg8::Unit& u, int wr, int wc, int fr, int fq, int ui, PG8_LAS unsigned char* lds) const {
#pragma unroll
        for (int ai = 0; ai < 2; ++ai) {
            f32x4 xv[4][2][2]; size_t off[4]; float rsv[4];
#pragma unroll
            for (int m = 0; m < 4; ++m) {
                const int rl = ai * 128 + wr * 64 + m * 16 + fr, row = u.pm * 256 + rl;
                rsv[m] = ((const PG8_LAS f32x2*)(lds + LDS_TAB))[(ui & 1) * 256 + rl].y;
                const float* xr;
                if (row < 16384) { off[m] = (size_t)row * 1024 + O_YP; xr = p.x_prompt + (size_t)row * 1024; }
                else { off[m] = (size_t)(row - 16384) * 1024 + O_YS; xr = p.x_sample + (size_t)(row - 16384) * 1024; }
#pragma unroll
                for (int bj = 0; bj < 2; ++bj)
#pragma unroll
                    for (int n = 0; n < 2; ++n) xv[m][bj][n] = *(const f32x4*)(xr + u.pn * 256 + 128 * bj + 32 * wc + 8 * fq + 4 * n);
            }
#pragma unroll
            for (int m = 0; m < 4; ++m) {
                float* yo = p.out + off[m];
#pragma unroll
                for (int bj = 0; bj < 2; ++bj)
#pragma unroll
                    for (int n = 0; n < 2; ++n) *(f32x4*)(yo + u.pn * 256 + 128 * bj + 32 * wc + 8 * fq + 4 * n) = xv[m][bj][n] + acc[ai][bj][m][n] * rsv[m];
            }
            asm volatile("" ::: "memory");
        }
    }
};

DEVI void phase1(const P& p, PG8_LAS unsigned char* lds) {
    pg8::Gemm g{(const bf16_t*)(p.ws + W_XB), (const bf16_t*)(p.ws + W_WINT), 1024, 1024, 1024};
    pg8::StaticOrder S; S.init(NROWS_PAD, 2304, gridDim.x, blockIdx.x);
    EpiP1 E{p};
    pg8::gemm_phase<EpiP1, pg8::StaticOrder>(lds, g, S, E);
    const int n3 = 621 - 2 * (int)gridDim.x;
    if ((int)blockIdx.x >= n3) deferred_prep(p, ((int)blockIdx.x - n3) * 512 + tidx(), ((int)gridDim.x - n3) * 512);
}
template <bool FIRST>
struct EpiOutHalf {
    static constexpr bool HAS_MID = false;
    P p;
    DEVI void begin(const pg8::Unit& u, int ui, int tid, PG8_LAS unsigned char* lds) const {
        if (tid < 256) {
            const int row = u.pm * 256 + tid;
            const float* ssq = (const float*)(p.ws + (FIRST ? W_SSQA : W_SSQS)) + (size_t)row * 8;
            const f32x4 a0 = *(const f32x4*)(ssq), a1 = *(const f32x4*)(ssq + 4);
            ((PG8_LAS float*)(lds + LDS_TAB))[(ui & 1) * 256 + tid] = rsqrtf(((a0[0] + a0[1]) + (a0[2] + a0[3]) + (a1[0] + a1[1]) + (a1[2] + a1[3])) * (1.f / 512.f) + EPS);
        }
    }
    DEVI void mid(f32x4 (&)[2][2][4][2], int, int, int, PG8_LAS unsigned char*) const {}
    DEVI void operator()(AccRef acc, const pg8::Unit& u, int wr, int wc, int fr, int fq, int ui, PG8_LAS unsigned char* lds) const {
#pragma unroll
        for (int ai = 0; ai < 2; ++ai)
#pragma unroll
            for (int m = 0; m < 4; ++m) {
                const int rl = ai * 128 + wr * 64 + m * 16 + fr, row = u.pm * 256 + rl;
                const float rsv = ((const PG8_LAS float*)(lds + LDS_TAB))[(ui & 1) * 256 + rl];
                const size_t o = (size_t)(row - 16384) * 1024; const float* xr = p.x_sample + o; float* yo = p.out + O_YS + o;
#pragma unroll
                for (int bj = 0; bj < 2; ++bj)
#pragma unroll
                    for (int n = 0; n < 2; ++n) { const int f = u.pn * 256 + 128 * bj + 32 * wc + 8 * fq + 4 * n;
                        const f32x4 base = FIRST ? *(const f32x4*)(xr + f) : *(const f32x4*)(yo + f); *(f32x4*)(yo + f) = base + acc[ai][bj][m][n] * rsv; }
                asm volatile("" ::: "memory");
            }
    }
};
struct SchedOne { int pm, pn; DEVI bool next(int i, pg8::Unit& u) const { if (i != 0) return false; u.pm = pm; u.pn = pn; return true; } };
DEVI void glu_unit(const P& p, PG8_LAS unsigned char* lds, int pm, int pn) {
    pg8::Gemm g{gb_base(p.ws, pm >= 64), (const bf16_t*)(p.ws + W_WGLUT), 512, 512, 512}; SchedOne S{pm, pn}; EpiGlu E{p};
    pg8::gemm_phase<EpiGlu, SchedOne>(lds, g, S, E);
}
DEVI void out_unit(const P& p, PG8_LAS unsigned char* lds, int pm, int pn) {
    pg8::Gemm g{(const bf16_t*)(p.ws + W_CAT), (const bf16_t*)(p.ws + W_WOUTT), 1024, 1024, 1024}; SchedOne S{pm, pn}; EpiOut E{p};
    pg8::gemm_phase<EpiOut, SchedOne>(lds, g, S, E);
}
template <bool FIRST>
DEVI void out_half_unit(const P& p, PG8_LAS unsigned char* lds, int pm, int pn) {
    pg8::Gemm g{(const bf16_t*)(p.ws + W_CAT) + (FIRST ? 0 : 512), (const bf16_t*)(p.ws + W_WOUTT) + (FIRST ? 0 : 512), 1024, 1024, 512}; SchedOne S{pm, pn}; EpiOutHalf<FIRST> E{p};
    pg8::gemm_phase<EpiOutHalf<FIRST>, SchedOne>(lds, g, S, E);
}
DEVI void phase2b_gemm(const P& p, PG8_LAS unsigned char* lds) {
    const int c = blockIdx.x;
    if (c >= 248) glu_unit(p, lds, 64 + ((c - 248) >> 1), (c - 248) & 1);
    else out_half_unit<true>(p, lds, 64 + ((c - 232) >> 2), (c - 232) & 3);
}
DEVI void phase3a(const P& p, PG8_LAS unsigned char* lds) {
    const int c = blockIdx.x;
    if (c < 128) { const int x = c & 7, s = c >> 3; glu_unit(p, lds, x * 8 + (s >> 1), s & 1); }
    else if (c < 144) out_half_unit<false>(p, lds, 64 + ((c - 128) >> 2), (c - 128) & 3);
}
DEVI void phase3b(const P& p, PG8_LAS unsigned char* lds) { const int c = blockIdx.x, x = c & 7, s = c >> 3; out_unit(p, lds, x * 8 + (s >> 2), s & 3); }

__global__ void __launch_bounds__(512, 2) hymba_fwd(P p) {
    extern __shared__ __attribute__((aligned(16))) unsigned char lds_dyn[];
    PG8_LAS unsigned char* lds = (PG8_LAS unsigned char*)lds_dyn;
    if (threadIdx.x < 16) ((PG8_LAS unsigned*)(lds + LDS_XB))[threadIdx.x] = 0u;
    __syncthreads();
    XcdBarrier xb = xcd_barrier_post((unsigned*)(p.ws + W_BAR), (volatile LAS unsigned*)(lds + LDS_XB));
#ifndef REP0
#define REP0 1
#define REP1 1
#define REP2A 1
#define REP2B 1
#define REP3A 1
#define REP3B 1
#endif
    for (int r = 0; r < REP0; ++r) { phase0(p); xcd_barrier(xb); }
    for (int r = 0; r < REP1; ++r) { phase1(p, lds); xcd_barrier(xb); }
    for (int r = 0; r < REP2A; ++r) { phase2a(p, (char*)lds_dyn); xcd_barrier(xb); }
    if (blockIdx.x < 232) phase2b(p, (char*)lds_dyn); else phase2b_gemm(p, lds);
    xcd_barrier(xb);
    for (int r = 0; r < REP3A; ++r) { phase3a(p, lds); xcd_barrier(xb); }
    for (int r = 0; r < REP3B; ++r) { phase3b(p, lds); if (r + 1 < REP3B) xcd_barrier(xb); }
}

extern "C" void kernel_launch(void* const* d_in, const int* in_sizes, int n_in, void* d_out, int out_size, void* d_ws, size_t ws_size, hipStream_t stream) {
    P p{};
    const float** pp = (const float**)&p;
    for (int i = 0; i < 25; ++i) pp[i] = (const float*)d_in[i];
    p.out = (float*)d_out; p.ws = (char*)d_ws;
    static int grid_blocks = 0;
    if (!grid_blocks) {
        int dev = 0, cus = 0, per_cu = 0;
        (void)hipGetDevice(&dev);
        (void)hipDeviceGetAttribute(&cus, hipDeviceAttributeMultiprocessorCount, dev);
        (void)hipFuncSetAttribute((const void*)hymba_fwd, hipFuncAttributeMaxDynamicSharedMemorySize, LDS_BYTES);
        (void)hipOccupancyMaxActiveBlocksPerMultiprocessor(&per_cu, hymba_fwd, 512, LDS_BYTES);
        if (per_cu < 1) fprintf(stderr, "occupancy query reports %d blocks per CU\n", per_cu);
        grid_blocks = cus;
    }
    (void)hipMemsetAsync((char*)d_ws + W_BAR, 0, 16384, stream);
    void* args[] = {&p};
    hipError_t e = hipLaunchCooperativeKernel((void*)hymba_fwd, dim3(grid_blocks), dim3(512), args, LDS_BYTES, stream);
    if (e != hipSuccess) fprintf(stderr, "cooperative launch failed: %s (grid %d)\n", hipGetErrorString(e), grid_blocks);
}
```
